# Optimizing an MI355X kernel written in HIP

```python
import math
import jax
import jax.numpy as jnp
from jax import lax
import numpy as np

D_MODEL = 1024
BATCH = 8
SEQ = 4096
DEPTH = 1

GRID_W = 64
CTX_LEN = 256
MIX_WIDTH = D_MODEL
FOURIER_HEAD_DIM = 64
FOURIER_WIDTH = MIX_WIDTH // 4
FOURIER_HEADS = FOURIER_WIDTH // FOURIER_HEAD_DIM
SSD_WIDTH = MIX_WIDTH - FOURIER_WIDTH
SSD_HEAD_DIM = 64
SSD_HEADS = SSD_WIDTH // SSD_HEAD_DIM
SSD_GROUPS = 4
SSD_STATE = 128
GROUP_STATE = SSD_GROUPS * SSD_STATE
CONV_WIDTH = 3
CHUNK = 128
D_FF = 2816
N_MOD = 9
MACARON_WEIGHT = 0.5
EPS = 1e-6
CONV_DIM = GROUP_STATE + SSD_WIDTH + GROUP_STATE
PROJ_WIDTH = FOURIER_WIDTH + SSD_WIDTH + CONV_DIM + 2 * SSD_HEADS

kernel_name = 'hybrid_fourier_ssd_dit_layer'


def rms_norm(x, g):
    x32 = x.astype(jnp.float32)
    y = x32 * lax.rsqrt(jnp.mean(x32 * x32, axis=-1, keepdims=True) + EPS)
    return (y * g.astype(jnp.float32)).astype(x.dtype)


def modulate(h, shift, scale):
    return h * (1 + scale[:, None, :]) + shift[:, None, :]


def macaron_ffn(x, mod3, norm_pre, norm_post, w_gate, w_up, w_down):
    h = modulate(rms_norm(x, norm_pre), mod3[:, 0], mod3[:, 1])
    y = (jax.nn.silu(h @ w_gate) * (h @ w_up)) @ w_down
    return x + MACARON_WEIGHT * mod3[:, 2][:, None, :] * rms_norm(y, norm_post)


def centred_dwconv_silu(u, w, b):
    out = lax.conv_general_dilated(u, w[:, None, :], (1,), 'SAME',
                                   dimension_numbers=('NWC', 'WIO', 'NWC'),
                                   feature_group_count=u.shape[-1])
    return jax.nn.silu(out + b)


def softplus_dt(dt_raw, dt_bias):
    b, L = dt_raw.shape[:2]
    return jax.nn.softplus(dt_raw.astype(jnp.float32).reshape(b, L, 2, SSD_HEADS)
                           + dt_bias.astype(jnp.float32))


def flip(t):
    return jnp.flip(t, axis=1)


def fourier_mix(u, fourier_w):
    b, L, _ = u.shape
    uh = u.reshape(b, L, FOURIER_HEADS, FOURIER_HEAD_DIM).astype(jnp.float32)
    f = jnp.fft.fft2(uh, axes=(1, 3), norm='ortho').real.astype(u.dtype)
    return jnp.einsum('blhd,hde->blhe', f, fourier_w).reshape(b, L, FOURIER_WIDTH)


def ssd_chunked(xs, dt, a, bm, cm, h0):
    b, L = xs.shape[:2]
    nc = L // CHUNK
    R = SSD_HEADS // SSD_GROUPS
    xdt = (xs * dt[..., None]).reshape(b, nc, CHUNK, SSD_GROUPS, R, SSD_HEAD_DIM)
    a_cs = jnp.cumsum(jnp.transpose((dt * a).reshape(b, nc, CHUNK, SSD_GROUPS, R), (0, 1, 3, 4, 2)), axis=-1)
    bc = bm.reshape(b, nc, CHUNK, SSD_GROUPS, SSD_STATE)
    cc = cm.reshape(b, nc, CHUNK, SSD_GROUPS, SSD_STATE)
    lower = jnp.tril(jnp.ones((CHUNK, CHUNK), dtype=bool))
    seg = jnp.exp(jnp.where(lower, a_cs[..., :, None] - a_cs[..., None, :], -jnp.inf))
    cb = jnp.einsum('bclgn,bcsgn->bcgls', cc, bc)
    y_diag = jnp.einsum('bcgls,bcgrls,bcsgrp->bclgrp', cb, seg, xdt)
    states = jnp.einsum('bcsgn,bcgrs,bcsgrp->bcgrpn', bc, jnp.exp(a_cs[..., -1:] - a_cs), xdt)

    def step(h, inp):
        s, d = inp
        return h * d[..., None, None] + s, h

    h_last, h_prev = lax.scan(step, h0.reshape(b, SSD_GROUPS, R, SSD_HEAD_DIM, SSD_STATE),
                              (jnp.moveaxis(states, 1, 0), jnp.moveaxis(jnp.exp(a_cs[..., -1]), 1, 0)))
    y_off = jnp.einsum('bclgn,cbgrpn,bcgrl->bclgrp', cc, h_prev, jnp.exp(a_cs))
    y = (y_diag + y_off).reshape(b, L, SSD_HEADS, SSD_HEAD_DIM)
    return y, h_last.reshape(b, SSD_HEADS, SSD_HEAD_DIM, SSD_STATE)


def ssd_final_state(xs, dt, a, bm):
    b, L = xs.shape[:2]
    R = SSD_HEADS // SSD_GROUPS
    cs = jnp.cumsum(dt * a, axis=1)
    xdt = (xs * (dt * jnp.exp(cs[:, -1:] - cs))[..., None]).reshape(b, L, SSD_GROUPS, R, SSD_HEAD_DIM)
    return jnp.einsum('blgn,blgrp->bgrpn', bm, xdt).reshape(b, SSD_HEADS, SSD_HEAD_DIM, SSD_STATE)


def mix_sublayer(x, mod3, h0_f, h0_b, norm_pre, norm_post, w_in, fourier_w, conv_w, conv_b,
                 dt_bias, a_log, d_skip, ssd_norm, w_out):
    b, L, _ = x.shape
    h = modulate(rms_norm(x, norm_pre), mod3[:, 0], mod3[:, 1])
    u_f, z, xbc, dt_raw = jnp.split(h @ w_in, [FOURIER_WIDTH, FOURIER_WIDTH + SSD_WIDTH,
                                               FOURIER_WIDTH + SSD_WIDTH + CONV_DIM], axis=-1)
    xbc = centred_dwconv_silu(xbc, conv_w, conv_b)
    cm, xs, bm = jnp.split(xbc, [GROUP_STATE, GROUP_STATE + SSD_WIDTH], axis=-1)
    xs = xs.reshape(b, L, SSD_HEADS, SSD_HEAD_DIM)
    bm = bm.reshape(b, L, SSD_GROUPS, SSD_STATE)
    cm = cm.reshape(b, L, SSD_GROUPS, SSD_STATE)
    dt = softplus_dt(dt_raw, dt_bias)
    a = -jnp.exp(a_log.astype(jnp.float32))
    y_f, h_f = ssd_chunked(xs, dt[:, :, 0], a[0], bm, cm, h0_f)
    y_b, h_b = ssd_chunked(flip(xs), flip(dt[:, :, 1]), a[1], flip(bm), flip(cm), h0_b)
    y = y_f + flip(y_b) + d_skip.astype(jnp.float32)[:, None] * xs
    y = y.reshape(b, L, SSD_WIDTH).astype(x.dtype) * jax.nn.silu(z)
    y = rms_norm(y.reshape(b, L, SSD_GROUPS, SSD_WIDTH // SSD_GROUPS),
                 ssd_norm.reshape(SSD_GROUPS, SSD_WIDTH // SSD_GROUPS)).reshape(b, L, SSD_WIDTH)
    out = jnp.concatenate([fourier_mix(u_f, fourier_w), y], axis=-1) @ w_out
    return x + mod3[:, 2][:, None, :] * rms_norm(out, norm_post), h_f, h_b


def context_states(ctx, mod3, norm_pre, w_in, conv_w, conv_b, dt_bias, a_log):
    b, L, _ = ctx.shape
    h = modulate(rms_norm(ctx, norm_pre), mod3[:, 0], mod3[:, 1])
    xb, dt_raw = jnp.split(h @ w_in[:, FOURIER_WIDTH + SSD_WIDTH + GROUP_STATE:],
                           [SSD_WIDTH + GROUP_STATE], axis=-1)
    xb = centred_dwconv_silu(xb, conv_w[:, GROUP_STATE:], conv_b[GROUP_STATE:])
    xs, bm = jnp.split(xb, [SSD_WIDTH], axis=-1)
    xs = xs.reshape(b, L, SSD_HEADS, SSD_HEAD_DIM)
    bm = bm.reshape(b, L, SSD_GROUPS, SSD_STATE)
    dt = softplus_dt(dt_raw, dt_bias)
    a = -jnp.exp(a_log.astype(jnp.float32))
    h_f = ssd_final_state(xs, dt[:, :, 0], a[0], bm)
    h_b = ssd_final_state(flip(xs), flip(dt[:, :, 1]), a[1], flip(bm))
    return h_f, h_b


def setup_inputs(seed: int = 0) -> dict:
    key = jax.random.key(seed)
    ks = iter(jax.random.split(key, 32))
    f32 = jnp.float32
    L = DEPTH

    def normal(shape, scale=1.0):
        return scale * jax.random.normal(next(ks), shape, f32)

    def gain(shape):
        return 1.0 + 0.1 * jax.random.normal(next(ks), shape, f32)

    d = {}
    d['x'] = normal((BATCH, SEQ, D_MODEL))
    d['c'] = normal((BATCH, D_MODEL))
    d['ctx'] = normal((BATCH, CTX_LEN, D_MODEL))
    d['c_ctx'] = normal((D_MODEL,))
    d['ada_w'] = normal((L, D_MODEL, N_MOD * D_MODEL), D_MODEL ** -0.5)
    d['ada_b'] = normal((L, N_MOD * D_MODEL), 0.02)
    d['ffn1_norm_pre'] = gain((L, D_MODEL))
    d['ffn1_norm_post'] = gain((L, D_MODEL))
    d['ffn1_w_gate'] = normal((L, D_MODEL, D_FF), D_MODEL ** -0.5)
    d['ffn1_w_up'] = normal((L, D_MODEL, D_FF), D_MODEL ** -0.5)
    d['ffn1_w_down'] = normal((L, D_FF, D_MODEL), D_FF ** -0.5)
    d['mix_norm_pre'] = gain((L, D_MODEL))
    d['mix_norm_post'] = gain((L, D_MODEL))
    d['w_in'] = normal((L, D_MODEL, PROJ_WIDTH), D_MODEL ** -0.5)
    d['fourier_w'] = normal((L, FOURIER_HEADS, FOURIER_HEAD_DIM, FOURIER_HEAD_DIM), FOURIER_HEAD_DIM ** -0.5)
    d['conv_w'] = normal((L, CONV_WIDTH, CONV_DIM), CONV_WIDTH ** -0.5)
    d['conv_b'] = normal((L, CONV_DIM), 0.02)
    dt_init = jnp.exp(jax.random.uniform(next(ks), (L, 2, SSD_HEADS), f32, math.log(1e-3), math.log(1e-1)))
    d['dt_bias'] = dt_init + jnp.log(-jnp.expm1(-dt_init))
    d['a_log'] = jnp.log(jax.random.uniform(next(ks), (L, 2, SSD_HEADS), f32, 1.0, 16.0))
    d['d_skip'] = gain((L, SSD_HEADS))
    d['ssd_norm'] = gain((L, SSD_WIDTH))
    d['w_out'] = normal((L, MIX_WIDTH, D_MODEL), MIX_WIDTH ** -0.5)
    d['ffn2_norm_pre'] = gain((L, D_MODEL))
    d['ffn2_norm_post'] = gain((L, D_MODEL))
    d['ffn2_w_gate'] = normal((L, D_MODEL, D_FF), D_MODEL ** -0.5)
    d['ffn2_w_up'] = normal((L, D_MODEL, D_FF), D_MODEL ** -0.5)
    d['ffn2_w_down'] = normal((L, D_FF, D_MODEL), D_FF ** -0.5)
    return d


def reference(x, c, ctx, c_ctx, ada_w, ada_b, ffn1_norm_pre, ffn1_norm_post, ffn1_w_gate, ffn1_w_up,
              ffn1_w_down, mix_norm_pre, mix_norm_post, w_in, fourier_w, conv_w, conv_b, dt_bias, a_log,
              d_skip, ssd_norm, w_out, ffn2_norm_pre, ffn2_norm_post, ffn2_w_gate, ffn2_w_up, ffn2_w_down):
    b = x.shape[0]
    for layer in range(DEPTH):
        mod = (jax.nn.silu(c) @ ada_w[layer] + ada_b[layer]).reshape(b, N_MOD, D_MODEL)
        mod_ctx = (jax.nn.silu(c_ctx) @ ada_w[layer] + ada_b[layer]).reshape(1, N_MOD, D_MODEL)
        ffn1 = (ffn1_norm_pre[layer], ffn1_norm_post[layer], ffn1_w_gate[layer], ffn1_w_up[layer], ffn1_w_down[layer])
        ffn2 = (ffn2_norm_pre[layer], ffn2_norm_post[layer], ffn2_w_gate[layer], ffn2_w_up[layer], ffn2_w_down[layer])
        mix = (mix_norm_pre[layer], mix_norm_post[layer], w_in[layer], fourier_w[layer], conv_w[layer],
               conv_b[layer], dt_bias[layer], a_log[layer], d_skip[layer], ssd_norm[layer], w_out[layer])

        x = macaron_ffn(x, mod[:, 0:3], *ffn1)
        ctx = macaron_ffn(ctx, mod_ctx[:, 0:3], *ffn1)

        if layer + 1 < DEPTH:
            zeros = jnp.zeros((b, SSD_HEADS, SSD_HEAD_DIM, SSD_STATE), jnp.float32)
            ctx, h_ctx_f, h_ctx_b = mix_sublayer(ctx, mod_ctx[:, 3:6], zeros, zeros, *mix)
        else:
            h_ctx_f, h_ctx_b = context_states(ctx, mod_ctx[:, 3:6], mix_norm_pre[layer], w_in[layer],
                                              conv_w[layer], conv_b[layer], dt_bias[layer], a_log[layer])

        x, _, _ = mix_sublayer(x, mod[:, 3:6], h_ctx_f, h_ctx_b, *mix)

        x = macaron_ffn(x, mod[:, 6:9], *ffn2)
        if layer + 1 < DEPTH:
            ctx = macaron_ffn(ctx, mod_ctx[:, 6:9], *ffn2)
    return x
```

```cpp
#include <hip/hip_runtime.h>
#include <cstdio>
#include <cstdint>
namespace pg8 {
#define PG8_LAS __attribute__((address_space(3)))
typedef unsigned short bf16_t;
typedef short bf16x8 __attribute__((ext_vector_type(8)));
typedef float f32x4 __attribute__((ext_vector_type(4)));
typedef unsigned u32x4 __attribute__((ext_vector_type(4)));
constexpr int BM = 256, BK = 64, HALF = 128, HTB = HALF * BK * 2  , STAGE_BYTES = 8 * HTB, NXCD = 8, WGM = 8;

__host__ __device__ __forceinline__ int lds_byte(int r, int c) { const int st = (r >> 4) * 2 + (c >> 5), rr = r & 15, cc = c & 31, ob = rr * 64 + cc * 2; return st * 1024 + (ob ^ (((ob >> 9) & 1) << 5)); }
__host__ __device__ __forceinline__ void stage_rc(int b, int& R, int& C) { const int st = b / 1024, sb = b % 1024, swz = sb ^ (((sb >> 9) & 1) << 5); R = (st >> 1) * 16 + swz / 64; C = (st & 1) * 32 + (swz % 64) / 2; }
__host__ __device__ __forceinline__ int perm32(int rho) { const int n = rho >> 4, i = rho & 15; return 8 * (i >> 2) + 4 * n + (i & 3); }

struct Unit { int pm, pn; };
struct Gemm { const bf16_t* A; const bf16_t* Bt; int M, N, K; };

struct StaticOrder {
    int nM, nN, nwg, G, c;
    __host__ __device__ void init(int M, int N, int G_, int c_) { nM = M / BM; nN = N / BM; nwg = nM * nN; G = G_; c = c_; }
    __host__ __device__ bool next(int i, Unit& u) const {
        const long L = (long)i * G + c; if (L >= nwg) return false;
        int wgid = (int)L; { const int q = nwg / NXCD, r = nwg % NXCD, xcd = wgid % NXCD, off = wgid / NXCD; wgid = (xcd < r ? xcd * (q + 1) : r * (q + 1) + (xcd - r) * q) + off; }
        const int nig = WGM * nN, gid = wgid / nig, fm = gid * WGM, gsz = (nM - fm) < WGM ? (nM - fm) : WGM;
        u.pm = fm + ((wgid % nig) % gsz); u.pn = (wgid % nig) / gsz; return true;
    }
    __device__ __forceinline__ void a_ready(const Unit&) const {}
    __device__ __forceinline__ void done(const Unit&) const {}
};
__device__ __forceinline__ unsigned cvt_pk_bf16(float lo, float hi) { unsigned r; asm volatile("v_cvt_pk_bf16_f32 %0, %1, %2" : "=v"(r) : "v"(lo), "v"(hi)); return r; }
typedef float f32x2 __attribute__((ext_vector_type(2)));
__device__ __forceinline__ float silu_f(float g) { return g * __builtin_amdgcn_rcpf(1.0f + __expf(-g)); }

struct EpiF32 {
    static constexpr bool PERM = false, AFTER_DRAIN = false;
    float* C; int ldc;
    __device__ __forceinline__ void operator()(const f32x4 (&acc)[2][2][4][2], const Unit& u, int wr, int wc, int fr, int fq) const {
        const int row0 = u.pm * BM + wr * 64 + fr, col0 = u.pn * BM + wc * 32 + 4 * fq;
#pragma unroll
        for (int ai = 0; ai < 2; ++ai)
#pragma unroll
            for (int m = 0; m < 4; ++m) { float* rowp = C + (size_t)(row0 + ai * HALF + m * 16) * ldc + col0;
#pragma unroll
                for (int bj = 0; bj < 2; ++bj)
#pragma unroll
                    for (int n = 0; n < 2; ++n) *(f32x4*)(rowp + bj * HALF + n * 16) = acc[ai][bj][m][n]; }
    }
};
struct EpiSwiGLU {
    static constexpr bool PERM = true, AFTER_DRAIN = false;
    bf16_t* O; int ldo;
    __device__ __forceinline__ void operator()(const f32x4 (&acc)[2][2][4][2], const Unit& u, int wr, int wc, int fr, int fq) const {
        const int row0 = u.pm * BM + wr * 64 + fr, col0 = u.pn * HALF + wc * 32 + 8 * fq;
#pragma unroll
        for (int ai = 0; ai < 2; ++ai)
#pragma unroll
            for (int m = 0; m < 4; ++m) { bf16_t* rowp = O + (size_t)(row0 + ai * HALF + m * 16) * ldo + col0;
                const f32x4 g0 = acc[ai][0][m][0], g1 = acc[ai][0][m][1], u0 = acc[ai][1][m][0], u1 = acc[ai][1][m][1];
                u32x4 w;
                w.x = cvt_pk_bf16(silu_f(g0[0]) * u0[0], silu_f(g0[1]) * u0[1]); w.y = cvt_pk_bf16(silu_f(g0[2]) * u0[2], silu_f(g0[3]) * u0[3]);
                w.z = cvt_pk_bf16(silu_f(g1[0]) * u1[0], silu_f(g1[1]) * u1[1]); w.w = cvt_pk_bf16(silu_f(g1[2]) * u1[2], silu_f(g1[3]) * u1[3]);
                *(u32x4*)rowp = w; }
    }
};
struct EpiProj {
    static constexpr bool PERM = true, AFTER_DRAIN = false;
    bf16_t* O; int ldo; float* DT;
    __device__ __forceinline__ void operator()(const f32x4 (&acc)[2][2][4][2], const Unit& u, int wr, int wc, int fr, int fq) const {
        const int row0 = u.pm * BM + wr * 64 + fr;
        if (u.pn < 11) {
            const int col0 = u.pn * BM + wc * 32 + 8 * fq;
#pragma unroll
            for (int ai = 0; ai < 2; ++ai)
#pragma unroll
                for (int m = 0; m < 4; ++m) { bf16_t* rowp = O + (size_t)(row0 + ai * HALF + m * 16) * ldo + col0;
#pragma unroll
                    for (int bj = 0; bj < 2; ++bj) { const f32x4 v0 = acc[ai][bj][m][0], v1 = acc[ai][bj][m][1];
                        u32x4 w; w.x = cvt_pk_bf16(v0[0], v0[1]); w.y = cvt_pk_bf16(v0[2], v0[3]); w.z = cvt_pk_bf16(v1[0], v1[1]); w.w = cvt_pk_bf16(v1[2], v1[3]);
                        *(u32x4*)(rowp + bj * HALF) = w; } }
        } else if (wc == 0) {
#pragma unroll
            for (int ai = 0; ai < 2; ++ai)
#pragma unroll
                for (int m = 0; m < 4; ++m) { float* rowp = DT + (size_t)(row0 + ai * HALF + m * 16) * 32 + 8 * fq;
                    *(f32x4*)rowp = acc[ai][0][m][0]; *(f32x4*)(rowp + 4) = acc[ai][0][m][1]; }
        }
    }
};
template <class Epi, class Sched, bool ALIGN_EPI = false, bool SP2 = false>
__device__ __forceinline__ void gemm_phase(PG8_LAS unsigned char* lds, const Gemm g, const Sched& S, const Epi& E) {
    const int tid = threadIdx.x, wid = __builtin_amdgcn_readfirstlane(tid >> 6), lane = tid & 63, wr = wid >> 2, wc = wid & 3, fr = lane & 15, fq = lane >> 4;
    const int K = g.K, nt = K / BK;
    unsigned voffA[2], voffB[2];
#pragma unroll
    for (int i = 0; i < 2; ++i) { int R, C; stage_rc(tid * 16 + i * 8192, R, C); const int Rb = Epi::PERM ? ((R & ~31) + perm32(R & 31)) : R;
        voffA[i] = (unsigned)(R * K + C) * 2u; voffB[i] = (unsigned)(Rb * K + C) * 2u; }
    const size_t kstep = (size_t)(BK * 2);
    const size_t hstep = (size_t)HALF * K * 2;
    const size_t tstep = 2 * hstep;
    const unsigned ldsw = (unsigned)wid * 1024u;
    const int aoff = lds_byte(wr * 64 + fr, fq * 8), boff = lds_byte(wc * 32 + fr, fq * 8);
#define PG8_SA(b, h) (((b) * 2 + (h)) * HTB)
#define PG8_SB(b, h) ((4 + (b) * 2 + (h)) * HTB)
#define PG8_STAGE(bufoff, gbase, voff) do { _Pragma("unroll") for (int _i = 0; _i < 2; ++_i) \
        __builtin_amdgcn_global_load_lds((const unsigned*)((const char*)(gbase) + (voff)[_i]), (PG8_LAS unsigned*)(lds + (bufoff) + ldsw + _i * 8192), 16, 0, 0); } while (0)
#define PG8_LDA(dst, b, h) do { _Pragma("unroll") for (int m = 0; m < 4; ++m) _Pragma("unroll") for (int k = 0; k < 2; ++k) dst[m][k] = *(const PG8_LAS bf16x8*)(lds + PG8_SA(b, h) + aoff + m * 2048 + k * 1024); } while (0)
#define PG8_LDB(dst, b, h) do { _Pragma("unroll") for (int n = 0; n < 2; ++n) _Pragma("unroll") for (int k = 0; k < 2; ++k) dst[n][k] = *(const PG8_LAS bf16x8*)(lds + PG8_SB(b, h) + boff + n * 2048 + k * 1024); } while (0)
#define PG8_MMA(ai, bj, At, Bt) do { __builtin_amdgcn_s_setprio(1); _Pragma("unroll") for (int m = 0; m < 4; ++m) _Pragma("unroll") for (int n = 0; n < 2; ++n) _Pragma("unroll") for (int k = 0; k < 2; ++k) \
        acc[ai][bj][m][n] = __builtin_amdgcn_mfma_f32_16x16x32_bf16(Bt[n][k], At[m][k], acc[ai][bj][m][n], 0, 0, 0); __builtin_amdgcn_s_setprio(0); } while (0)
#define PG8_WAIT_V(n) asm volatile("s_waitcnt vmcnt(" #n ")" ::: "memory")
#define PG8_WAIT_L(n) asm volatile("s_waitcnt lgkmcnt(" #n ")" ::: "memory")
#define PG8_BAR __builtin_amdgcn_s_barrier()
#define PG8_SCHED __builtin_amdgcn_sched_barrier(0)
    Unit cur, nxt; int ui = 0;
    if (!S.next(0, cur)) return;
    f32x4 acc[2][2][4][2];
#pragma unroll
    for (int a = 0; a < 2; ++a)
#pragma unroll
        for (int b = 0; b < 2; ++b)
#pragma unroll
            for (int m = 0; m < 4; ++m)
#pragma unroll
                for (int n = 0; n < 2; ++n) acc[a][b][m][n] = (f32x4){0.f, 0.f, 0.f, 0.f};
    bf16x8 At[4][2], B0[2][2], B1[2][2];
    const char* cA = (const char*)g.A + (size_t)cur.pm * tstep; const char* cB = (const char*)g.Bt + (size_t)cur.pn * tstep;
    S.a_ready(cur);
    if constexpr (SP2) {
        PG8_STAGE(PG8_SB(0, 0), cB, voffB); PG8_STAGE(PG8_SB(0, 1), cB + hstep, voffB); PG8_STAGE(PG8_SA(0, 0), cA, voffA); PG8_STAGE(PG8_SA(0, 1), cA + hstep, voffA);
        if (wr == 1) PG8_BAR;
        PG8_WAIT_V(2); PG8_BAR;
        PG8_STAGE(PG8_SB(1, 0), cB + kstep, voffB); PG8_STAGE(PG8_SA(1, 0), cA + kstep, voffA); PG8_STAGE(PG8_SB(1, 1), cB + hstep + kstep, voffB);
        PG8_WAIT_V(6); PG8_BAR;
    } else {
        PG8_STAGE(PG8_SB(0, 0), cB, voffB); PG8_STAGE(PG8_SA(0, 0), cA, voffA); PG8_STAGE(PG8_SB(0, 1), cB + hstep, voffB); PG8_STAGE(PG8_SA(0, 1), cA + hstep, voffA);
        if (wr == 1) PG8_BAR;
        PG8_WAIT_V(4); PG8_BAR;
        PG8_STAGE(PG8_SB(1, 0), cB + kstep, voffB); PG8_STAGE(PG8_SA(1, 0), cA + kstep, voffA); PG8_STAGE(PG8_SB(1, 1), cB + hstep + kstep, voffB);
        PG8_WAIT_V(6); PG8_BAR;
    }
    for (;;) {
        const bool has_next = S.next(ui + 1, nxt);
        const char* nA = has_next ? (const char*)g.A + (size_t)nxt.pm * tstep : cA; const char* nB = has_next ? (const char*)g.Bt + (size_t)nxt.pn * tstep : cB;
        for (int t = 0; t < nt; t += 2) {
            const bool last = (t == nt - 2);
            const char* a1 = cA + (size_t)(t + 1) * kstep;
            const char* a2 = last ? nA : cA + (size_t)(t + 2) * kstep; const char* b2 = last ? nB : cB + (size_t)(t + 2) * kstep;
            const char* a3 = a2 + kstep; const char* b3 = b2 + kstep;
            if (last && has_next) S.a_ready(nxt);
            if constexpr (SP2) {
            PG8_LDB(B0, 0, 0); PG8_LDB(B1, 0, 1); PG8_SCHED; PG8_LDA(At, 0, 0); PG8_STAGE(PG8_SA(1, 1), a1 + hstep, voffA);
            PG8_WAIT_V(8); PG8_WAIT_L(0); PG8_BAR; PG8_MMA(0, 0, At, B0); PG8_MMA(0, 1, At, B1); PG8_BAR; PG8_SCHED;
            PG8_LDA(At, 0, 1); PG8_STAGE(PG8_SB(0, 0), b2, voffB); PG8_STAGE(PG8_SB(0, 1), b2 + hstep, voffB); PG8_STAGE(PG8_SA(0, 0), a2, voffA);
            PG8_WAIT_V(8); PG8_WAIT_L(0); PG8_BAR; PG8_MMA(1, 0, At, B0); PG8_MMA(1, 1, At, B1); PG8_BAR; PG8_SCHED;
            PG8_LDB(B0, 1, 0); PG8_LDB(B1, 1, 1); PG8_SCHED; PG8_LDA(At, 1, 0); PG8_STAGE(PG8_SA(0, 1), a2 + hstep, voffA);
            PG8_WAIT_V(8); PG8_WAIT_L(0); PG8_BAR; PG8_MMA(0, 0, At, B0); PG8_MMA(0, 1, At, B1); PG8_BAR; PG8_SCHED;
            PG8_LDA(At, 1, 1); PG8_STAGE(PG8_SB(1, 0), b3, voffB); PG8_STAGE(PG8_SB(1, 1), b3 + hstep, voffB); PG8_STAGE(PG8_SA(1, 0), a3, voffA);
            PG8_WAIT_V(8); PG8_WAIT_L(0); PG8_BAR; PG8_MMA(1, 0, At, B0); PG8_MMA(1, 1, At, B1); PG8_BAR; PG8_SCHED;
            } else {
            PG8_LDB(B0, 0, 0); PG8_SCHED; PG8_LDA(At, 0, 0); PG8_STAGE(PG8_SA(1, 1), a1 + hstep, voffA);
            PG8_WAIT_L(8); PG8_BAR; PG8_WAIT_L(0); PG8_MMA(0, 0, At, B0); PG8_BAR; PG8_SCHED;
            PG8_LDB(B1, 0, 1); PG8_STAGE(PG8_SB(0, 0), b2, voffB);
            PG8_BAR; PG8_WAIT_L(0); PG8_MMA(0, 1, At, B1); PG8_BAR;
            PG8_LDA(At, 0, 1); PG8_STAGE(PG8_SA(0, 0), a2, voffA);
            PG8_BAR; PG8_WAIT_L(0); PG8_MMA(1, 0, At, B0); PG8_BAR; PG8_SCHED;
            PG8_STAGE(PG8_SB(0, 1), b2 + hstep, voffB);
            PG8_WAIT_V(6); PG8_BAR; PG8_MMA(1, 1, At, B1); PG8_BAR;
            PG8_LDB(B0, 1, 0); PG8_SCHED; PG8_LDA(At, 1, 0); PG8_STAGE(PG8_SA(0, 1), a2 + hstep, voffA);
            PG8_WAIT_L(8); PG8_BAR; PG8_WAIT_L(0); PG8_MMA(0, 0, At, B0); PG8_BAR; PG8_SCHED;
            PG8_LDB(B1, 1, 1); PG8_STAGE(PG8_SB(1, 0), b3, voffB);
            PG8_BAR; PG8_WAIT_L(0); PG8_MMA(0, 1, At, B1); PG8_BAR;
            PG8_LDA(At, 1, 1); PG8_STAGE(PG8_SA(1, 0), a3, voffA);
            PG8_BAR; PG8_WAIT_L(0); PG8_MMA(1, 0, At, B0); PG8_BAR; PG8_SCHED;
            PG8_STAGE(PG8_SB(1, 1), b3 + hstep, voffB);
            PG8_WAIT_V(6); PG8_BAR; PG8_MMA(1, 1, At, B1); PG8_BAR;
            }
        }
        if constexpr (ALIGN_EPI) { if (wr == 0) PG8_BAR; }
        if constexpr (!Epi::AFTER_DRAIN) { E(acc, cur, wr, wc, fr, fq); S.done(cur); }
        if (!has_next) break;
#pragma unroll
        for (int a = 0; a < 2; ++a)
#pragma unroll
            for (int b = 0; b < 2; ++b)
#pragma unroll
                for (int m = 0; m < 4; ++m)
#pragma unroll
                    for (int n = 0; n < 2; ++n) acc[a][b][m][n] = (f32x4){0.f, 0.f, 0.f, 0.f};
        cur = nxt; cA = nA; cB = nB; ++ui;
        if constexpr (ALIGN_EPI) { if (wr == 1) PG8_BAR; }
    }
    PG8_WAIT_V(0);
    if constexpr (!ALIGN_EPI) { if (wr == 0) PG8_BAR; }
    PG8_BAR;
    if constexpr (Epi::AFTER_DRAIN) { E.fused(acc, cur, wr, wc, fr, fq, lds, wid, lane); S.done(cur); }
#undef PG8_SA
#undef PG8_SB
#undef PG8_STAGE
#undef PG8_LDA
#undef PG8_LDB
#undef PG8_MMA
#undef PG8_WAIT_V
#undef PG8_WAIT_L
#undef PG8_BAR
#undef PG8_SCHED
}
}

constexpr int NWAVES = 8;
constexpr int D = 1024, NB = 8, SEQ = 4096, CTXL = 256, T = NB * SEQ, TC = NB * CTXL, ROWS = T + TC;
constexpr int FF = 2816, NPROJ = 2840, NPROJ_PAD = 3072, KOUT = 1280, NMOD = 9 * D;
constexpr float EPS = 1e-6f;
constexpr int PC_U = 0, PC_Z = 256, PC_XBC = 1024, PROJ_LD = 2816;
constexpr size_t MiB = 1u << 20;
constexpr size_t WS_CTL = 0, CTL_ZERO_BYTES = 1 * MiB;
constexpr size_t WS_MOD = 65536;
constexpr size_t WS_WGU1 = 1 * MiB, WS_WD1 = 12 * MiB, WS_WGU2 = 18 * MiB, WS_WD2 = 29 * MiB, WS_WIN = 35 * MiB, WS_WOUT = 41 * MiB;
constexpr size_t WS_DT = 44 * MiB;
constexpr size_t WS_R1 = 49 * MiB;
constexpr size_t WS_R3 = 236 * MiB;
constexpr size_t WS_R4 = 355 * MiB;
constexpr size_t WS_R5 = 403 * MiB;
constexpr size_t WS_END = 507 * MiB;
constexpr int CW_BAR = 4096;

constexpr int RING_OFF = 0, RING_BYTES = 131072;
constexpr int LDSCTL_OFF = RING_BYTES, MISC_OFF = LDSCTL_OFF + 320, TRIG_OFF = LDSCTL_OFF + 1024;
constexpr int LDS_BYTES = 147456;

#define GAS __attribute__((address_space(1)))
#define LAS __attribute__((address_space(3)))
typedef unsigned short bf16;
typedef unsigned v4u __attribute__((ext_vector_type(4)));
typedef unsigned v2u __attribute__((ext_vector_type(2)));
typedef float f32x4 __attribute__((ext_vector_type(4)));
typedef GAS unsigned gu32;
#define LDS_WAIT() asm volatile("s_waitcnt lgkmcnt(0)" ::: "memory")
__device__ __forceinline__ unsigned f2bf(float f) { unsigned u = __builtin_bit_cast(unsigned, f); return (u + 0x7fffu + ((u >> 16) & 1u)) >> 16; }
__device__ __forceinline__ unsigned pk2(float lo, float hi) { return f2bf(lo) | (f2bf(hi) << 16); }
__device__ __forceinline__ float bflo(unsigned w) { return __uint_as_float(w << 16); }
__device__ __forceinline__ float bfhi(unsigned w) { return __uint_as_float(w & 0xffff0000u); }
__device__ __forceinline__ float bf2f(bf16 b) { return __uint_as_float((unsigned)b << 16); }
__device__ __forceinline__ float silu(float g) { return g / (1.0f + __expf(-g)); }
__device__ __forceinline__ float softplus(float v) { return fmaxf(v, 0.f) + log1pf(__expf(-fabsf(v))); }
__device__ __forceinline__ float wave_sum(float v) {
#pragma unroll
    for (int o = 1; o < 64; o <<= 1) v += __shfl_xor(v, o);
    return v;
}

#define XB_TMO      128
#define XB_XCNT(j)  (256  + 64 * (j))
#define XB_XSUB(j)  (1280 + 64 * (j))
#define XB_XGEN(j)  (2304 + 64 * (j))
#define XB_TOP      3328
#define XB_TOPGEN   3392
#define XCD_BAR_WORDS 3456
#define XB_SPIN_CAP (1u << 28)

__device__ __forceinline__ unsigned xb_ld(unsigned* p)              { return __hip_atomic_load(p, __ATOMIC_RELAXED, __HIP_MEMORY_SCOPE_AGENT); }
__device__ __forceinline__ unsigned xb_add(unsigned* p, unsigned v) { return __hip_atomic_fetch_add(p, v, __ATOMIC_RELAXED, __HIP_MEMORY_SCOPE_AGENT); }
__device__ __forceinline__ unsigned xb_xcc_id() { return (unsigned)__builtin_amdgcn_s_getreg((3 << 11) | 20) & 0xFu; }
#define XB_SPIN(cond, bar) do { unsigned _sp = 0; while (cond) { __builtin_amdgcn_s_sleep(1); \
    if ((++_sp & 255u) == 0u) { if (xb_ld(&(bar)[XB_TMO])) break; if (_sp > XB_SPIN_CAP) { atomicAdd(&(bar)[XB_TMO], 1u); break; } } } } while (0)

struct XcdBarrier {
    unsigned* bar; unsigned x;
    volatile LAS unsigned* st;
};

__device__ __forceinline__ XcdBarrier xcd_barrier_post(unsigned* bar, volatile LAS unsigned* st) {
    XcdBarrier b; b.bar = bar; b.x = xb_xcc_id(); b.st = st;
    if (threadIdx.x == 0) (void)xb_add(&bar[XB_XCNT(b.x)], 1u);
    return b;
}
__device__ __forceinline__ void xcd_barrier_complete(unsigned* bar, unsigned x, unsigned& nloc, unsigned& nx) {
    const unsigned G = gridDim.x * gridDim.y * gridDim.z;
    unsigned sum, cnt, mine, sp = 0u;
    for (;;) {
        sum = 0u; cnt = 0u; mine = 0u;
#pragma unroll
        for (unsigned j = 0; j < 16; ++j) { const unsigned c = xb_ld(&bar[XB_XCNT(j)]); sum += c; cnt += (c > 0u) ? 1u : 0u; mine = (j == x) ? c : mine; }
        if (sum == G) break;
        __builtin_amdgcn_s_sleep(1);
        if ((++sp & 255u) == 0u) { if (xb_ld(&bar[XB_TMO])) break; if (sp > XB_SPIN_CAP) { atomicAdd(&bar[XB_TMO], 1u); break; } }
    }
    nloc = mine > 0u ? mine : 1u; nx = cnt > 0u ? cnt : 1u;
}

__device__ __forceinline__ void xcd_barrier(const XcdBarrier& b) {
    asm volatile("s_waitcnt vmcnt(0)" ::: "memory");
    __syncthreads();
    if (threadIdx.x == 0) {
        unsigned* bar = b.bar;
        __builtin_amdgcn_s_waitcnt(0);
        unsigned nloc = b.st[0], nx = b.st[1];
        if (nloc == 0u) { xcd_barrier_complete(bar, b.x, nloc, nx); b.st[0] = nloc; b.st[1] = nx; }
        const unsigned old = xb_add(&bar[XB_XSUB(b.x)], 1u);
        const unsigned gen = old / nloc;
        if (old + 1u == (gen + 1u) * nloc) {
            __builtin_amdgcn_fence(__ATOMIC_RELEASE, "agent");
            asm volatile("s_waitcnt vmcnt(0)" ::: "memory");
            const unsigned og = xb_add(&bar[XB_TOP], 1u);
            const unsigned tg = og / nx;
            if (og + 1u == (tg + 1u) * nx) xb_add(&bar[XB_TOPGEN], 1u);
            else XB_SPIN(xb_ld(&bar[XB_TOPGEN]) == tg, bar);
            __builtin_amdgcn_fence(__ATOMIC_ACQUIRE, "agent");
            xb_add(&bar[XB_XGEN(b.x)], 1u);
            asm volatile("s_waitcnt vmcnt(0)" ::: "memory");
        } else {
            XB_SPIN(xb_ld(&bar[XB_XGEN(b.x)]) == gen, bar);
            __builtin_amdgcn_fence(__ATOMIC_ACQUIRE, "agent");
            asm volatile("s_waitcnt vmcnt(0)" ::: "memory");
        }
    }
    __syncthreads();
}


struct Args { const float* in[27]; float* out; unsigned char* ws; };
enum { I_X = 0, I_C, I_CTX, I_CCTX, I_ADAW, I_ADAB, I_F1PRE, I_F1POST, I_F1G, I_F1U, I_F1D, I_MPRE, I_MPOST, I_WIN, I_FW, I_CONVW, I_CONVB, I_DTB, I_ALOG, I_DSKIP, I_SSDN, I_WOUT,
       I_F2PRE, I_F2POST, I_F2G, I_F2U, I_F2D };

struct Frame {
    LAS unsigned char* lds;
    int tid, lane, wave, vcu, G, gw, NGW;
    const Args* a;
};

__device__ __forceinline__ void transpose_item(const float* W, int K, int N, bf16* WT, int dstld, int koff, int mode, LAS float* scr, int item, int lane) {
    const int nblk = (N + 31) / 32, kb = item / nblk, nb = item % nblk, k0 = 64 * kb, n0 = 32 * nb;
    const int nn = n0 + (lane & 31);
#pragma unroll 8
    for (int i = 0; i < 32; ++i) { const int kk = 2 * i + (lane >> 5); scr[kk * 33 + (lane & 31)] = (nn < N) ? W[(size_t)(k0 + kk) * N + nn] : 0.f; }
    LDS_WAIT(); asm volatile("" ::: "memory");
    const int c = lane & 7;
#pragma unroll
    for (int j = 0; j < 4; ++j) { const int nl = (lane >> 3) + 8 * j, n = n0 + nl; const LAS float* s = scr + (8 * c) * 33 + nl;
        v4u o; o.x = pk2(s[0 * 33], s[1 * 33]); o.y = pk2(s[2 * 33], s[3 * 33]); o.z = pk2(s[4 * 33], s[5 * 33]); o.w = pk2(s[6 * 33], s[7 * 33]);
        const int row = (mode == 0) ? n : (256 * (n >> 7) + (n & 127) + (mode == 2 ? 128 : 0));
        if (n < N) *(GAS v4u*)(WT + (size_t)row * dstld + koff + k0 + 8 * c) = o; }
    LDS_WAIT(); asm volatile("" ::: "memory");
}

__device__ __forceinline__ void fold_item(const float* fw, const float* wout, bf16* WoT, const LAS float* trig, int item, int lane) {
    const int nq = item & 3, dblk = (item >> 2) & 7, cs = (item >> 5) & 1, h = item >> 6;
    float t[8];
#pragma unroll
    for (int j = 0; j < 8; ++j) t[j] = 0.f;
    for (int m = 0; m < 64; ++m) { const float f = fw[(h * 64 + m) * 64 + lane];
#pragma unroll
        for (int j = 0; j < 8; ++j) { const int d = 8 * dblk + j; t[j] += trig[cs * 64 + ((d * m) & 63)] * f; } }
    f32x4 acc[8];
#pragma unroll
    for (int j = 0; j < 8; ++j) { t[j] *= (1.0f / 512.0f); acc[j] = (f32x4){0.f, 0.f, 0.f, 0.f}; }
    const int n = nq * 256 + lane * 4;
    for (int e = 0; e < 64; ++e) { const f32x4 w = *(const f32x4*)(wout + (size_t)(64 * h + e) * D + n);
#pragma unroll
        for (int j = 0; j < 8; ++j) { const float tj = __shfl(t[j], e); acc[j] += w * tj; } }
#pragma unroll
    for (int q = 0; q < 4; ++q) { v4u o; o.x = pk2(acc[0][q], acc[1][q]); o.y = pk2(acc[2][q], acc[3][q]); o.z = pk2(acc[4][q], acc[5][q]); o.w = pk2(acc[6][q], acc[7][q]);
        *(GAS v4u*)(WoT + (size_t)(n + q) * KOUT + cs * 256 + 64 * h + 8 * dblk) = o; }
}

__device__ __forceinline__ void mod_item_wg(const float* adaw, const float* adab, float* mod, const LAS float* sc, LAS float* red, int item, int wave, int lane, int tid) {
    const int kq = lane >> 4, c4 = lane & 15, col = item * 64 + 4 * c4;
    f32x4 acc[9];
#pragma unroll
    for (int r = 0; r < 9; ++r) acc[r] = (f32x4){0.f, 0.f, 0.f, 0.f};
#pragma unroll 8
    for (int s = 0; s < 32; ++s) { const int row = 128 * wave + 4 * s + kq; const f32x4 w = *(const f32x4*)(adaw + (size_t)row * NMOD + col);
#pragma unroll
        for (int r = 0; r < 9; ++r) acc[r] += w * sc[r * D + row]; }
#pragma unroll
    for (int r = 0; r < 9; ++r)
#pragma unroll
        for (int q = 0; q < 4; ++q) { float v = acc[r][q]; v += __shfl_xor(v, 16); v += __shfl_xor(v, 32); if (kq == 0) red[(wave * 9 + r) * 64 + 4 * c4 + q] = v; }
    __syncthreads();
    for (int o = tid; o < 9 * 64; o += NWAVES * 64) { const int r = o >> 6, c = o & 63; float v = adab[item * 64 + c];
#pragma unroll
        for (int w = 0; w < NWAVES; ++w) v += red[(w * 9 + r) * 64 + c];
        mod[r * NMOD + item * 64 + c] = v; }
}

__device__ __forceinline__ void row_load(const float* p, int lane, f32x4 (&v)[4]) {
#pragma unroll
    for (int j = 0; j < 4; ++j) v[j] = *(const f32x4*)(p + 4 * (lane + 64 * j));
}
__device__ __forceinline__ float row_sumsq(const f32x4 (&v)[4]) {
    float s = 0.f;
#pragma unroll
    for (int j = 0; j < 4; ++j) s += (v[j][0] * v[j][0] + v[j][1] * v[j][1]) + (v[j][2] * v[j][2] + v[j][3] * v[j][3]);
    return wave_sum(s);
}
__device__ __forceinline__ void row_mod_store(const f32x4 (&v)[4], float rstd, const float* g, const float* shift, const float* scale, bf16* orow, int lane) {
#pragma unroll
    for (int j = 0; j < 4; ++j) { const int c = 4 * (lane + 64 * j);
        const f32x4 gg = *(const f32x4*)(g + c), sh = *(const f32x4*)(shift + c), sc = *(const f32x4*)(scale + c);
        const f32x4 o = (v[j] * rstd * gg) * (sc + 1.0f) + sh;
        v2u w; w.x = pk2(o[0], o[1]); w.y = pk2(o[2], o[3]);
        *(GAS v2u*)(orow + c) = w; }
}
__device__ __forceinline__ void row_residual(f32x4 (&v)[4], const float* yrow, const float* base, const float* gpost, const float* gate, float gwt, int lane) {
    f32x4 y[4]; row_load(yrow, lane, y);
    const float ry = 1.0f / sqrtf(row_sumsq(y) * (1.0f / D) + EPS);
#pragma unroll
    for (int j = 0; j < 4; ++j) { const int c = 4 * (lane + 64 * j);
        const f32x4 b = *(const f32x4*)(base + c), gp = *(const f32x4*)(gpost + c), gt = *(const f32x4*)(gate + c);
        v[j] = b + gt * gwt * (y[j] * ry * gp); }
}
__device__ __forceinline__ void row_store(float* p, int lane, const f32x4 (&v)[4]) {
#pragma unroll
    for (int j = 0; j < 4; ++j) *(f32x4*)(p + 4 * (lane + 64 * j)) = v[j];
}


#define DBG_HASHED 0
#ifndef DBG_STAGE
#define DBG_STAGE 0
#endif
__device__ __forceinline__ float dbg_hash(float v) { unsigned u = __float_as_uint(v); u *= 2654435761u; u ^= u >> 15; u *= 2246822519u; u ^= u >> 13; return (float)((int)(u & 0xffffu) - 32768) * (1.0f / 32.0f); }
#define DBG_DUMP(stage, expr) do { if (DBG_STAGE == (stage)) { for (size_t i_ = (size_t)gw * 64 + lane; i_ < (size_t)T * D; i_ += (size_t)NGW * 64) { const size_t row_ = i_ >> 10, col_ = i_ & 1023; OUT[i_] = DBG_HASHED ? dbg_hash(expr) : (expr); } return; } } while (0)
__global__ void __launch_bounds__(NWAVES * 64, 2) mk_fwd(Args args) {
    extern __shared__ __attribute__((aligned(16))) unsigned char lds_raw[];
    Frame F;
    F.lds = (LAS unsigned char*)lds_raw;
    F.tid = threadIdx.x; F.lane = F.tid & 63; F.wave = __builtin_amdgcn_readfirstlane(F.tid >> 6);
    F.G = gridDim.x; { const int bx = blockIdx.x; F.vcu = (F.G % 8 == 0) ? (bx % 8) * (F.G / 8) + bx / 8 : bx; }
    F.gw = F.vcu * NWAVES + F.wave; F.NGW = F.G * NWAVES;
    const int lane = F.lane, gw = F.gw, NGW = F.NGW;
    unsigned char* ws = args.ws;
    const float* const* in = args.in;
    gu32* ctl = (gu32*)(ws + WS_CTL);
    float* mod = (float*)(ws + WS_MOD);
    bf16* Wgu1 = (bf16*)(ws + WS_WGU1); bf16* Wd1 = (bf16*)(ws + WS_WD1); bf16* Wgu2 = (bf16*)(ws + WS_WGU2); bf16* Wd2 = (bf16*)(ws + WS_WD2);
    bf16* Win = (bf16*)(ws + WS_WIN); bf16* WoT = (bf16*)(ws + WS_WOUT);
    float* dtraw = (float*)(ws + WS_DT);
    bf16* Hb = (bf16*)(ws + WS_R5);
    bf16* ACT = (bf16*)(ws + WS_R1);
    bf16* PROJ = (bf16*)(ws + WS_R1);
    float* Y1 = (float*)(ws + WS_R3);
    float* Y2 = (float*)(ws + WS_R1);
    float* Y3 = (float*)(ws + WS_R3);
    float* Zr = (float*)(ws + WS_R3); float* Zi = Zr + (size_t)NB * 64 * 64 * 256;
    bf16* A4 = (bf16*)(ws + WS_R3 + 64 * MiB);
    float* YT = (float*)(ws + WS_R5);
    float* OUT = args.out;

    for (int u = F.tid; u < (LDS_BYTES - LDSCTL_OFF) / 4; u += NWAVES * 64) ((LAS unsigned*)(F.lds + LDSCTL_OFF))[u] = 0u;
    __syncthreads();
    LAS float* trig = (LAS float*)(F.lds + TRIG_OFF);
    if (F.tid < 64) { trig[F.tid] = cospif((float)F.tid / 32.0f); trig[64 + F.tid] = sinpif((float)F.tid / 32.0f); }
    XcdBarrier bar = xcd_barrier_post((unsigned*)(ctl + CW_BAR), (volatile LAS unsigned*)(F.lds + MISC_OFF) + 8);
    __syncthreads();

    {
        LAS float* sc = (LAS float*)(F.lds + RING_OFF);
        for (int i = F.tid; i < 9 * D; i += NWAVES * 64) { const int r = i >> 10, k = i & 1023; const float v = (r < 8) ? in[I_C][r * D + k] : in[I_CCTX][k]; sc[i] = silu(v); }
        __syncthreads();
        LAS float* scr = (LAS float*)(F.lds + RING_OFF + 40960 + F.wave * 8448);
        if (F.vcu < 144) mod_item_wg(in[I_ADAW], in[I_ADAB], mod, sc, (LAS float*)(F.lds + RING_OFF + 110592), F.vcu, F.wave, lane, F.tid);
        constexpr int I_FOLD = 256, I_MODN = 0, I_GU = 16 * 88, I_DN = 44 * 32, I_WINN = 16 * 89, I_WO = 12 * 32;
        constexpr int NITEMS = I_FOLD + I_MODN + 2 * (2 * I_GU + I_DN) + I_WINN + I_WO;
        for (int it = gw; it < NITEMS; it += NGW) {
            int r = it;
            if (r < I_FOLD) { fold_item(in[I_FW], in[I_WOUT], WoT, trig, r, lane); continue; } r -= I_FOLD;
            if (r < I_GU) { transpose_item(in[I_F1G], D, FF, Wgu1, D, 0, 1, scr, r, lane); continue; } r -= I_GU;
            if (r < I_GU) { transpose_item(in[I_F1U], D, FF, Wgu1, D, 0, 2, scr, r, lane); continue; } r -= I_GU;
            if (r < I_DN) { transpose_item(in[I_F1D], FF, D, Wd1, FF, 0, 0, scr, r, lane); continue; } r -= I_DN;
            if (r < I_GU) { transpose_item(in[I_F2G], D, FF, Wgu2, D, 0, 1, scr, r, lane); continue; } r -= I_GU;
            if (r < I_GU) { transpose_item(in[I_F2U], D, FF, Wgu2, D, 0, 2, scr, r, lane); continue; } r -= I_GU;
            if (r < I_DN) { transpose_item(in[I_F2D], FF, D, Wd2, FF, 0, 0, scr, r, lane); continue; } r -= I_DN;
            if (r < I_WINN) { transpose_item(in[I_WIN], D, NPROJ, Win, D, 0, 0, scr, r, lane); continue; } r -= I_WINN;
            transpose_item(in[I_WOUT] + (size_t)256 * D, 768, D, WoT, KOUT, 512, 0, scr, r, lane);
        }
        { GAS v4u* z = (GAS v4u*)(Win + (size_t)NPROJ * D); const int nz = (NPROJ_PAD - NPROJ) * D / 8;
          for (int i = gw * 64 + lane; i < nz; i += NGW * 64) z[i] = (v4u){0u, 0u, 0u, 0u}; }
    }
    xcd_barrier(bar);

    for (int row = gw; row < ROWS; row += NGW) {
        const float* src = row < T ? in[I_X] + (size_t)row * D : in[I_CTX] + (size_t)(row - T) * D;
        const float* mb = mod + (size_t)(row < T ? (row >> 12) : 8) * NMOD;
        f32x4 v[4]; row_load(src, lane, v);
        const float rs = 1.0f / sqrtf(row_sumsq(v) * (1.0f / D) + EPS);
        row_mod_store(v, rs, in[I_F1PRE], mb + 0 * D, mb + 1 * D, Hb + (size_t)row * D, lane);
    }
    xcd_barrier(bar);
    DBG_DUMP(1, bf2f(Hb[row_ * D + col_]));

    { pg8::Gemm g{Hb, Wgu1, ROWS, 2 * FF, D}; pg8::StaticOrder S; S.init(ROWS, 2 * FF, F.G, (int)blockIdx.x);
      pg8::EpiSwiGLU E{ACT, FF};
      pg8::gemm_phase<pg8::EpiSwiGLU, pg8::StaticOrder, true, true>(F.lds + RING_OFF, g, S, E); }
    xcd_barrier(bar);
    DBG_DUMP(2, bf2f(ACT[row_ * FF + col_]));
    { pg8::Gemm g{ACT, Wd1, ROWS, D, FF}; pg8::StaticOrder S; S.init(ROWS, D, F.G, (int)blockIdx.x);
      pg8::EpiF32 E{Y1, D};
      pg8::gemm_phase<pg8::EpiF32, pg8::StaticOrder, true, true>(F.lds + RING_OFF, g, S, E); }
    xcd_barrier(bar);
    DBG_DUMP(3, Y1[row_ * D + col_]);
    for (int row = gw; row < ROWS; row += NGW) {
        const float* base = row < T ? in[I_X] + (size_t)row * D : in[I_CTX] + (size_t)(row - T) * D;
        const float* mb = mod + (size_t)(row < T ? (row >> 12) : 8) * NMOD;
        f32x4 v[4]; row_residual(v, Y1 + (size_t)row * D, base, in[I_F1POST], mb + 2 * D, 0.5f, lane);
        if (row < T) row_store(OUT + (size_t)row * D, lane, v);
        const float rs = 1.0f / sqrtf(row_sumsq(v) * (1.0f / D) + EPS);
        row_mod_store(v, rs, in[I_MPRE], mb + 3 * D, mb + 4 * D, Hb + (size_t)row * D, lane);
    }
    xcd_barrier(bar);
    DBG_DUMP(4, bf2f(Hb[row_ * D + col_]));
    { pg8::Gemm g{Hb, Win, ROWS, NPROJ_PAD, D}; pg8::StaticOrder S; S.init(ROWS, NPROJ_PAD, F.G, (int)blockIdx.x);
      pg8::EpiProj E{PROJ, PROJ_LD, dtraw};
      pg8::gemm_phase<pg8::EpiProj, pg8::StaticOrder, true, true>(F.lds + RING_OFF, g, S, E); }
    xcd_barrier(bar);
    DBG_DUMP(5, bf2f(PROJ[row_ * PROJ_LD + 1024 + col_]) + (col_ < 24 ? dtraw[row_ * 32 + col_] : 0.f));

    {
        const int GT = F.G * NWAVES * 64, gtid = F.vcu * NWAVES * 64 + F.tid;
        for (int idx = gtid; idx < NB * 64 * 64 * 256; idx += GT) {
            const int ch = idx & 255, l2 = (idx >> 8) & 63, k1 = (idx >> 14) & 63, b = idx >> 20;
            float yr = 0.f, yi = 0.f;
            for (int l1 = 0; l1 < 64; ++l1) { const float uv = bf2f(PROJ[(size_t)(b * SEQ + 64 * l1 + l2) * PROJ_LD + PC_U + ch]); const int j = (k1 * l1) & 63; yr += trig[j] * uv; yi -= trig[64 + j] * uv; }
            const float ang = (float)(k1 * l2) / 2048.0f, tc = cospif(ang), ts = sinpif(ang);
            Zr[idx] = yr * tc + yi * ts; Zi[idx] = yi * tc - yr * ts;
        }
        const float* convw = in[I_CONVW]; const float* convb = in[I_CONVB];
        for (int item = gw; item < NB * 12 * 64; item += NGW) {
            const int b = item / 768, h = (item / 64) % 12, p = item & 63, g = h / 3;
            const int cB = 1280 + g * 128 + 2 * lane, cC = g * 128 + 2 * lane, cX = 512 + h * 64 + p;
            float wB0[3], wB1[3], wC0[3], wC1[3], wX[3];
#pragma unroll
            for (int j = 0; j < 3; ++j) { wB0[j] = convw[j * 1792 + cB]; wB1[j] = convw[j * 1792 + cB + 1]; wC0[j] = convw[j * 1792 + cC]; wC1[j] = convw[j * 1792 + cC + 1]; wX[j] = convw[j * 1792 + cX]; }
            const float bB0 = convb[cB], bB1 = convb[cB + 1], bC0 = convb[cC], bC1 = convb[cC + 1], bX = convb[cX];
            const float dsk = in[I_DSKIP][h];
            for (int dir = 0; dir < 2; ++dir) {
                const float av = -__expf(in[I_ALOG][dir * 12 + h]), dtb = in[I_DTB][dir * 12 + h];
                float hs0 = 0.f, hs1 = 0.f;
                for (int seg = 0; seg < 2; ++seg) {
                    const int len = seg == 0 ? CTXL : SEQ, rbase = seg == 0 ? T + b * CTXL : b * SEQ;
                    for (int st = 0; st < len; ++st) {
                        const int l = dir == 0 ? st : len - 1 - st, row = rbase + l;
                        const bf16* pr = PROJ + (size_t)row * PROJ_LD + PC_XBC;
                        float aB0 = bB0, aB1 = bB1, aC0 = bC0, aC1 = bC1, aX = bX;
#pragma unroll
                        for (int j = 0; j < 3; ++j) { const int lj = l + j - 1; if (lj >= 0 && lj < len) { const bf16* q = pr + (ptrdiff_t)(j - 1) * PROJ_LD;
                            const unsigned wb = *(const unsigned*)(q + cB), wc = *(const unsigned*)(q + cC);
                            aB0 += wB0[j] * bflo(wb); aB1 += wB1[j] * bfhi(wb); aC0 += wC0[j] * bflo(wc); aC1 += wC1[j] * bfhi(wc); aX += wX[j] * bf2f(q[cX]); } }
                        const float vB0 = silu(aB0), vB1 = silu(aB1), vX = silu(aX);
                        const float dt = softplus(dtraw[(size_t)row * 32 + dir * 12 + h] + dtb), dA = __expf(dt * av), w = dt * vX;
                        hs0 = dA * hs0 + w * vB0; hs1 = dA * hs1 + w * vB1;
                        if (seg == 1) { const float vC0 = silu(aC0), vC1 = silu(aC1);
                            float yv = wave_sum(vC0 * hs0 + vC1 * hs1);
                            float* yp = YT + (size_t)row * 768 + h * 64 + p;
                            if (lane == 0) { if (dir == 0) *yp = yv + dsk * vX; else *yp += yv; } }
                    }
                }
            }
        }
    }
    xcd_barrier(bar);
    DBG_DUMP(6, col_ < 768 ? YT[row_ * 768 + col_] : Zr[row_ * 256 + (col_ - 768)]);
    DBG_DUMP(10, col_ < 768 ? YT[row_ * 768 + col_] : 0.f);
    {
        const int GT = F.G * NWAVES * 64, gtid = F.vcu * NWAVES * 64 + F.tid;
        for (int idx = gtid; idx < NB * 64 * 64 * 256; idx += GT) {
            const int ch = idx & 255, k2 = (idx >> 8) & 63, k1 = (idx >> 14) & 63, b = idx >> 20;
            float gr = 0.f, gi = 0.f;
            for (int l2 = 0; l2 < 64; ++l2) { const size_t zi = ((size_t)(b * 64 + k1) * 64 + l2) * 256 + ch; const float zr = Zr[zi], zim = Zi[zi]; const int j = (k2 * l2) & 63; const float c = trig[j], s = trig[64 + j];
                gr += c * zr + s * zim; gi += c * zim - s * zr; }
            bf16* o = A4 + (size_t)(b * SEQ + k1 + 64 * k2) * KOUT + ch;
            o[0] = (bf16)f2bf(gr); o[256] = (bf16)f2bf(gi);
        }
        const float* ssdn = in[I_SSDN];
        for (int row = gw; row < T; row += NGW) {
            const float* yp = YT + (size_t)row * 768 + 12 * lane; const bf16* zp = PROJ + (size_t)row * PROJ_LD + PC_Z + 12 * lane;
            float v[12]; float ss = 0.f;
#pragma unroll
            for (int q = 0; q < 3; ++q) { const f32x4 yv = *(const f32x4*)(yp + 4 * q); const v2u zw = *(const v2u*)(zp + 4 * q);
                v[4 * q + 0] = yv[0] * silu(bflo(zw.x)); v[4 * q + 1] = yv[1] * silu(bfhi(zw.x)); v[4 * q + 2] = yv[2] * silu(bflo(zw.y)); v[4 * q + 3] = yv[3] * silu(bfhi(zw.y)); }
#pragma unroll
            for (int q = 0; q < 12; ++q) ss += v[q] * v[q];
            ss += __shfl_xor(ss, 1); ss += __shfl_xor(ss, 2); ss += __shfl_xor(ss, 4); ss += __shfl_xor(ss, 8);
            const float rs = 1.0f / sqrtf(ss * (1.0f / 192.0f) + EPS);
            bf16* o = A4 + (size_t)row * KOUT + 512 + 12 * lane;
#pragma unroll
            for (int q = 0; q < 3; ++q) { const f32x4 gn = *(const f32x4*)(ssdn + 12 * lane + 4 * q);
                v2u w; w.x = pk2(v[4 * q] * rs * gn[0], v[4 * q + 1] * rs * gn[1]); w.y = pk2(v[4 * q + 2] * rs * gn[2], v[4 * q + 3] * rs * gn[3]);
                *(GAS v2u*)(o + 4 * q) = w; }
        }
    }
    xcd_barrier(bar);
    DBG_DUMP(7, bf2f(A4[row_ * KOUT + col_]));
    { pg8::Gemm g{A4, WoT, T, D, KOUT}; pg8::StaticOrder S; S.init(T, D, F.G, (int)blockIdx.x);
      pg8::EpiF32 E{Y2, D};
      pg8::gemm_phase<pg8::EpiF32, pg8::StaticOrder, true, true>(F.lds + RING_OFF, g, S, E); }
    xcd_barrier(bar);
    DBG_DUMP(8, Y2[row_ * D + col_]);
    if (DBG_STAGE == 12) {
      { pg8::Gemm g{A4, WoT, T, D, KOUT}; pg8::StaticOrder S; S.init(T, D, F.G, (int)blockIdx.x);
        pg8::EpiF32 E{OUT, D};
        pg8::gemm_phase<pg8::EpiF32, pg8::StaticOrder, true, true>(F.lds + RING_OFF, g, S, E); }
      xcd_barrier(bar);
      for (size_t i_ = (size_t)gw * 64 + lane; i_ < (size_t)T * D; i_ += (size_t)NGW * 64) OUT[i_] = OUT[i_] - Y2[i_];
      return;
    }
    DBG_DUMP(11, col_ < 768 ? bf2f(A4[row_ * KOUT + 512 + col_]) : 0.f);
    DBG_DUMP(9, row_ < 1280 ? bf2f(WoT[col_ * KOUT + row_]) : bf2f(A4[(row_ - 1280) * KOUT + 256 + col_]));
    for (int row = gw; row < T; row += NGW) {
        const float* mb = mod + (size_t)(row >> 12) * NMOD;
        f32x4 v[4]; row_residual(v, Y2 + (size_t)row * D, OUT + (size_t)row * D, in[I_MPOST], mb + 5 * D, 1.0f, lane);
        row_store(OUT + (size_t)row * D, lane, v);
        const float rs = 1.0f / sqrtf(row_sumsq(v) * (1.0f / D) + EPS);
        row_mod_store(v, rs, in[I_F2PRE], mb + 6 * D, mb + 7 * D, Hb + (size_t)row * D, lane);
    }
    xcd_barrier(bar);
    { pg8::Gemm g{Hb, Wgu2, T, 2 * FF, D}; pg8::StaticOrder S; S.init(T, 2 * FF, F.G, (int)blockIdx.x);
      pg8::EpiSwiGLU E{ACT, FF};
      pg8::gemm_phase<pg8::EpiSwiGLU, pg8::StaticOrder, true, true>(F.lds + RING_OFF, g, S, E); }
    xcd_barrier(bar);
    { pg8::Gemm g{ACT, Wd2, T, D, FF}; pg8::StaticOrder S; S.init(T, D, F.G, (int)blockIdx.x);
      pg8::EpiF32 E{Y3, D};
      pg8::gemm_phase<pg8::EpiF32, pg8::StaticOrder, true, true>(F.lds + RING_OFF, g, S, E); }
    xcd_barrier(bar);
    for (int row = gw; row < T; row += NGW) {
        const float* mb = mod + (size_t)(row >> 12) * NMOD;
        f32x4 v[4]; row_residual(v, Y3 + (size_t)row * D, OUT + (size_t)row * D, in[I_F2POST], mb + 8 * D, 0.5f, lane);
        row_store(OUT + (size_t)row * D, lane, v);
    }
}

extern "C" void kernel_launch(void* const* d_in, const int* in_sizes, int n_in, void* d_out, int out_size, void* d_ws, size_t ws_size, hipStream_t stream) {
    static int grid = 0;
    if (grid == 0) {
        if (n_in != 27 || in_sizes[0] != T * D || out_size != T * D || ws_size < WS_END) { fprintf(stderr, "kernel_launch: unexpected shapes (n_in %d, in0 %d, out %d, ws %zu)\n", n_in, n_in > 0 ? in_sizes[0] : -1, out_size, ws_size); grid = -1; return; }
        int dev = 0, cus = 0;
        if (hipGetDevice(&dev) != hipSuccess || hipDeviceGetAttribute(&cus, hipDeviceAttributeMultiprocessorCount, dev) != hipSuccess) { grid = -1; return; }
        if (hipFuncSetAttribute((const void*)mk_fwd, hipFuncAttributeMaxDynamicSharedMemorySize, LDS_BYTES) != hipSuccess) { fprintf(stderr, "kernel_launch: hipFuncSetAttribute failed\n"); grid = -1; return; }
        (void)hipGetLastError();
        grid = cus;
    }
    if (grid < 0) return;
    if (hipMemsetAsync((char*)d_ws + WS_CTL, 0, CTL_ZERO_BYTES, stream) != hipSuccess) return;
    Args a{};
    for (int i = 0; i < 27; ++i) a.in[i] = (const float*)d_in[i];
    a.out = (float*)d_out; a.ws = (unsigned char*)d_ws;
    hipLaunchKernelGGL(mk_fwd, dim3(grid), dim3(NWAVES * 64), LDS_BYTES, stream, a);
}
```

```cpp
#include <hip/hip_runtime.h>
#include <cstdio>
#include <cstdint>
namespace pg8 {
#define PG8_LAS __attribute__((address_space(3)))
typedef unsigned short bf16_t;
typedef short bf16x8 __attribute__((ext_vector_type(8)));
typedef float f32x4 __attribute__((ext_vector_type(4)));
typedef unsigned u32x4 __attribute__((ext_vector_type(4)));
constexpr int BM = 256, BK = 64, HALF = 128, HTB = HALF * BK * 2  , STAGE_BYTES = 8 * HTB, NXCD = 8, WGM = 8;

__host__ __device__ __forceinline__ int lds_byte(int r, int c) { const int st = (r >> 4) * 2 + (c >> 5), rr = r & 15, cc = c & 31, ob = rr * 64 + cc * 2; return st * 1024 + (ob ^ (((ob >> 9) & 1) << 5)); }
__host__ __device__ __forceinline__ void stage_rc(int b, int& R, int& C) { const int st = b / 1024, sb = b % 1024, swz = sb ^ (((sb >> 9) & 1) << 5); R = (st >> 1) * 16 + swz / 64; C = (st & 1) * 32 + (swz % 64) / 2; }
__host__ __device__ __forceinline__ int perm32(int rho) { const int n = rho >> 4, i = rho & 15; return 8 * (i >> 2) + 4 * n + (i & 3); }

struct Unit { int pm, pn; };
struct Gemm { const bf16_t* A; const bf16_t* Bt; int M, N, K; };

struct StaticOrder {
    int nM, nN, nwg, G, c;
    __host__ __device__ void init(int M, int N, int G_, int c_) { nM = M / BM; nN = N / BM; nwg = nM * nN; G = G_; c = c_; }
    __host__ __device__ bool next(int i, Unit& u) const {
        const long L = (long)i * G + c; if (L >= nwg) return false;
        int wgid = (int)L; { const int q = nwg / NXCD, r = nwg % NXCD, xcd = wgid % NXCD, off = wgid / NXCD; wgid = (xcd < r ? xcd * (q + 1) : r * (q + 1) + (xcd - r) * q) + off; }
        const int nig = WGM * nN, gid = wgid / nig, fm = gid * WGM, gsz = (nM - fm) < WGM ? (nM - fm) : WGM;
        u.pm = fm + ((wgid % nig) % gsz); u.pn = (wgid % nig) / gsz; return true;
    }
    __device__ __forceinline__ void a_ready(const Unit&) const {}
    __device__ __forceinline__ void done(const Unit&) const {}
};
__device__ __forceinline__ unsigned cvt_pk_bf16(float lo, float hi) { unsigned r; asm volatile("v_cvt_pk_bf16_f32 %0, %1, %2" : "=v"(r) : "v"(lo), "v"(hi)); return r; }
typedef float f32x2 __attribute__((ext_vector_type(2)));
__device__ __forceinline__ float silu_f(float g) { return g * __builtin_amdgcn_rcpf(1.0f + __expf(-g)); }

struct EpiF32 {
    static constexpr bool PERM = false, AFTER_DRAIN = false;
    float* C; int ldc;
    __device__ __forceinline__ void operator()(const f32x4 (&acc)[2][2][4][2], const Unit& u, int wr, int wc, int fr, int fq) const {
        const int row0 = u.pm * BM + wr * 64 + fr, col0 = u.pn * BM + wc * 32 + 4 * fq;
#pragma unroll
        for (int ai = 0; ai < 2; ++ai)
#pragma unroll
            for (int m = 0; m < 4; ++m) { float* rowp = C + (size_t)(row0 + ai * HALF + m * 16) * ldc + col0;
#pragma unroll
                for (int bj = 0; bj < 2; ++bj)
#pragma unroll
                    for (int n = 0; n < 2; ++n) *(f32x4*)(rowp + bj * HALF + n * 16) = acc[ai][bj][m][n]; }
    }
};
struct EpiSwiGLU {
    static constexpr bool PERM = true, AFTER_DRAIN = false;
    bf16_t* O; int ldo;
    __device__ __forceinline__ void operator()(const f32x4 (&acc)[2][2][4][2], const Unit& u, int wr, int wc, int fr, int fq) const {
        const int row0 = u.pm * BM + wr * 64 + fr, col0 = u.pn * HALF + wc * 32 + 8 * fq;
#pragma unroll
        for (int ai = 0; ai < 2; ++ai)
#pragma unroll
            for (int m = 0; m < 4; ++m) { bf16_t* rowp = O + (size_t)(row0 + ai * HALF + m * 16) * ldo + col0;
                const f32x4 g0 = acc[ai][0][m][0], g1 = acc[ai][0][m][1], u0 = acc[ai][1][m][0], u1 = acc[ai][1][m][1];
                u32x4 w;
                w.x = cvt_pk_bf16(silu_f(g0[0]) * u0[0], silu_f(g0[1]) * u0[1]); w.y = cvt_pk_bf16(silu_f(g0[2]) * u0[2], silu_f(g0[3]) * u0[3]);
                w.z = cvt_pk_bf16(silu_f(g1[0]) * u1[0], silu_f(g1[1]) * u1[1]); w.w = cvt_pk_bf16(silu_f(g1[2]) * u1[2], silu_f(g1[3]) * u1[3]);
                *(u32x4*)rowp = w; }
    }
};
struct EpiProj {
    static constexpr bool PERM = true, AFTER_DRAIN = false;
    bf16_t* U; bf16_t* Zg; bf16_t* XBC; float* DT; int nlat;
    __device__ __forceinline__ void operator()(const f32x4 (&acc)[2][2][4][2], const Unit& u, int wr, int wc, int fr, int fq) const {
        const int row0 = u.pm * BM + wr * 64 + fr;
        if (u.pn < 11) {
            bf16_t* dst; int ld, cb;
            if (u.pn == 0) { if (u.pm >= nlat) return; dst = U; ld = 256; cb = 0; }
            else if (u.pn < 4) { if (u.pm >= nlat) return; dst = Zg; ld = 768; cb = (u.pn - 1) * BM; }
            else { dst = XBC; ld = 1792; cb = (u.pn - 4) * BM; }
            const int col0 = cb + wc * 32 + 8 * fq;
#pragma unroll
            for (int ai = 0; ai < 2; ++ai)
#pragma unroll
                for (int m = 0; m < 4; ++m) { bf16_t* rowp = dst + (size_t)(row0 + ai * HALF + m * 16) * ld + col0;
#pragma unroll
                    for (int bj = 0; bj < 2; ++bj) { const f32x4 v0 = acc[ai][bj][m][0], v1 = acc[ai][bj][m][1];
                        u32x4 w; w.x = cvt_pk_bf16(v0[0], v0[1]); w.y = cvt_pk_bf16(v0[2], v0[3]); w.z = cvt_pk_bf16(v1[0], v1[1]); w.w = cvt_pk_bf16(v1[2], v1[3]);
                        *(u32x4*)(rowp + bj * HALF) = w; } }
        } else if (wc == 0) {
#pragma unroll
            for (int ai = 0; ai < 2; ++ai)
#pragma unroll
                for (int m = 0; m < 4; ++m) { float* rowp = DT + (size_t)(row0 + ai * HALF + m * 16) * 32 + 8 * fq;
                    *(f32x4*)rowp = acc[ai][0][m][0]; *(f32x4*)(rowp + 4) = acc[ai][0][m][1]; }
        }
    }
};
template <class Epi, class Sched, bool ALIGN_EPI = false, bool SP2 = false>
__device__ __forceinline__ void gemm_phase(PG8_LAS unsigned char* lds, const Gemm g, const Sched& S, const Epi& E) {
    const int tid = threadIdx.x, wid = __builtin_amdgcn_readfirstlane(tid >> 6), lane = tid & 63, wr = wid >> 2, wc = wid & 3, fr = lane & 15, fq = lane >> 4;
    const int K = g.K, nt = K / BK;
    unsigned voffA[2], voffB[2];
#pragma unroll
    for (int i = 0; i < 2; ++i) { int R, C; stage_rc(tid * 16 + i * 8192, R, C); const int Rb = Epi::PERM ? ((R & ~31) + perm32(R & 31)) : R;
        voffA[i] = (unsigned)(R * K + C) * 2u; voffB[i] = (unsigned)(Rb * K + C) * 2u; }
    const size_t kstep = (size_t)(BK * 2);
    const size_t hstep = (size_t)HALF * K * 2;
    const size_t tstep = 2 * hstep;
    const unsigned ldsw = (unsigned)wid * 1024u;
    const int aoff = lds_byte(wr * 64 + fr, fq * 8), boff = lds_byte(wc * 32 + fr, fq * 8);
#define PG8_SA(b, h) (((b) * 2 + (h)) * HTB)
#define PG8_SB(b, h) ((4 + (b) * 2 + (h)) * HTB)
#define PG8_STAGE(bufoff, gbase, voff) do { _Pragma("unroll") for (int _i = 0; _i < 2; ++_i) \
        __builtin_amdgcn_global_load_lds((const unsigned*)((const char*)(gbase) + (voff)[_i]), (PG8_LAS unsigned*)(lds + (bufoff) + ldsw + _i * 8192), 16, 0, 0); } while (0)
#define PG8_LDA(dst, b, h) do { _Pragma("unroll") for (int m = 0; m < 4; ++m) _Pragma("unroll") for (int k = 0; k < 2; ++k) dst[m][k] = *(const PG8_LAS bf16x8*)(lds + PG8_SA(b, h) + aoff + m * 2048 + k * 1024); } while (0)
#define PG8_LDB(dst, b, h) do { _Pragma("unroll") for (int n = 0; n < 2; ++n) _Pragma("unroll") for (int k = 0; k < 2; ++k) dst[n][k] = *(const PG8_LAS bf16x8*)(lds + PG8_SB(b, h) + boff + n * 2048 + k * 1024); } while (0)
#define PG8_MMA(ai, bj, At, Bt) do { __builtin_amdgcn_s_setprio(1); _Pragma("unroll") for (int m = 0; m < 4; ++m) _Pragma("unroll") for (int n = 0; n < 2; ++n) _Pragma("unroll") for (int k = 0; k < 2; ++k) \
        acc[ai][bj][m][n] = __builtin_amdgcn_mfma_f32_16x16x32_bf16(Bt[n][k], At[m][k], acc[ai][bj][m][n], 0, 0, 0); __builtin_amdgcn_s_setprio(0); } while (0)
#define PG8_WAIT_V(n) asm volatile("s_waitcnt vmcnt(" #n ")" ::: "memory")
#define PG8_WAIT_L(n) asm volatile("s_waitcnt lgkmcnt(" #n ")" ::: "memory")
#define PG8_BAR __builtin_amdgcn_s_barrier()
#define PG8_SCHED __builtin_amdgcn_sched_barrier(0)
    Unit cur, nxt; int ui = 0;
    if (!S.next(0, cur)) return;
    f32x4 acc[2][2][4][2];
#pragma unroll
    for (int a = 0; a < 2; ++a)
#pragma unroll
        for (int b = 0; b < 2; ++b)
#pragma unroll
            for (int m = 0; m < 4; ++m)
#pragma unroll
                for (int n = 0; n < 2; ++n) acc[a][b][m][n] = (f32x4){0.f, 0.f, 0.f, 0.f};
    bf16x8 At[4][2], B0[2][2], B1[2][2];
    const char* cA = (const char*)g.A + (size_t)cur.pm * tstep; const char* cB = (const char*)g.Bt + (size_t)cur.pn * tstep;
    S.a_ready(cur);
    if constexpr (SP2) {
        PG8_STAGE(PG8_SB(0, 0), cB, voffB); PG8_STAGE(PG8_SB(0, 1), cB + hstep, voffB); PG8_STAGE(PG8_SA(0, 0), cA, voffA); PG8_STAGE(PG8_SA(0, 1), cA + hstep, voffA);
        if (wr == 1) PG8_BAR;
        PG8_WAIT_V(2); PG8_BAR;
        PG8_STAGE(PG8_SB(1, 0), cB + kstep, voffB); PG8_STAGE(PG8_SA(1, 0), cA + kstep, voffA); PG8_STAGE(PG8_SB(1, 1), cB + hstep + kstep, voffB);
        PG8_WAIT_V(6); PG8_BAR;
    } else {
        PG8_STAGE(PG8_SB(0, 0), cB, voffB); PG8_STAGE(PG8_SA(0, 0), cA, voffA); PG8_STAGE(PG8_SB(0, 1), cB + hstep, voffB); PG8_STAGE(PG8_SA(0, 1), cA + hstep, voffA);
        if (wr == 1) PG8_BAR;
        PG8_WAIT_V(4); PG8_BAR;
        PG8_STAGE(PG8_SB(1, 0), cB + kstep, voffB); PG8_STAGE(PG8_SA(1, 0), cA + kstep, voffA); PG8_STAGE(PG8_SB(1, 1), cB + hstep + kstep, voffB);
        PG8_WAIT_V(6); PG8_BAR;
    }
    for (;;) {
        const bool has_next = S.next(ui + 1, nxt);
        const char* nA = has_next ? (const char*)g.A + (size_t)nxt.pm * tstep : cA; const char* nB = has_next ? (const char*)g.Bt + (size_t)nxt.pn * tstep : cB;
        for (int t = 0; t < nt; t += 2) {
            const bool last = (t == nt - 2);
            const char* a1 = cA + (size_t)(t + 1) * kstep;
            const char* a2 = last ? nA : cA + (size_t)(t + 2) * kstep; const char* b2 = last ? nB : cB + (size_t)(t + 2) * kstep;
            const char* a3 = a2 + kstep; const char* b3 = b2 + kstep;
            if (last && has_next) S.a_ready(nxt);
            if constexpr (SP2) {
            PG8_LDB(B0, 0, 0); PG8_LDB(B1, 0, 1); PG8_SCHED; PG8_LDA(At, 0, 0); PG8_STAGE(PG8_SA(1, 1), a1 + hstep, voffA);
            PG8_WAIT_V(8); PG8_WAIT_L(0); PG8_BAR; PG8_MMA(0, 0, At, B0); PG8_MMA(0, 1, At, B1); PG8_BAR; PG8_SCHED;
            PG8_LDA(At, 0, 1); PG8_STAGE(PG8_SB(0, 0), b2, voffB); PG8_STAGE(PG8_SB(0, 1), b2 + hstep, voffB); PG8_STAGE(PG8_SA(0, 0), a2, voffA);
            PG8_WAIT_V(8); PG8_WAIT_L(0); PG8_BAR; PG8_MMA(1, 0, At, B0); PG8_MMA(1, 1, At, B1); PG8_BAR; PG8_SCHED;
            PG8_LDB(B0, 1, 0); PG8_LDB(B1, 1, 1); PG8_SCHED; PG8_LDA(At, 1, 0); PG8_STAGE(PG8_SA(0, 1), a2 + hstep, voffA);
            PG8_WAIT_V(8); PG8_WAIT_L(0); PG8_BAR; PG8_MMA(0, 0, At, B0); PG8_MMA(0, 1, At, B1); PG8_BAR; PG8_SCHED;
            PG8_LDA(At, 1, 1); PG8_STAGE(PG8_SB(1, 0), b3, voffB); PG8_STAGE(PG8_SB(1, 1), b3 + hstep, voffB); PG8_STAGE(PG8_SA(1, 0), a3, voffA);
            PG8_WAIT_V(8); PG8_WAIT_L(0); PG8_BAR; PG8_MMA(1, 0, At, B0); PG8_MMA(1, 1, At, B1); PG8_BAR; PG8_SCHED;
            } else {
            PG8_LDB(B0, 0, 0); PG8_SCHED; PG8_LDA(At, 0, 0); PG8_STAGE(PG8_SA(1, 1), a1 + hstep, voffA);
            PG8_WAIT_L(8); PG8_BAR; PG8_WAIT_L(0); PG8_MMA(0, 0, At, B0); PG8_BAR; PG8_SCHED;
            PG8_LDB(B1, 0, 1); PG8_STAGE(PG8_SB(0, 0), b2, voffB);
            PG8_BAR; PG8_WAIT_L(0); PG8_MMA(0, 1, At, B1); PG8_BAR;
            PG8_LDA(At, 0, 1); PG8_STAGE(PG8_SA(0, 0), a2, voffA);
            PG8_BAR; PG8_WAIT_L(0); PG8_MMA(1, 0, At, B0); PG8_BAR; PG8_SCHED;
            PG8_STAGE(PG8_SB(0, 1), b2 + hstep, voffB);
            PG8_WAIT_V(6); PG8_BAR; PG8_MMA(1, 1, At, B1); PG8_BAR;
            PG8_LDB(B0, 1, 0); PG8_SCHED; PG8_LDA(At, 1, 0); PG8_STAGE(PG8_SA(0, 1), a2 + hstep, voffA);
            PG8_WAIT_L(8); PG8_BAR; PG8_WAIT_L(0); PG8_MMA(0, 0, At, B0); PG8_BAR; PG8_SCHED;
            PG8_LDB(B1, 1, 1); PG8_STAGE(PG8_SB(1, 0), b3, voffB);
            PG8_BAR; PG8_WAIT_L(0); PG8_MMA(0, 1, At, B1); PG8_BAR;
            PG8_LDA(At, 1, 1); PG8_STAGE(PG8_SA(1, 0), a3, voffA);
            PG8_BAR; PG8_WAIT_L(0); PG8_MMA(1, 0, At, B0); PG8_BAR; PG8_SCHED;
            PG8_STAGE(PG8_SB(1, 1), b3 + hstep, voffB);
            PG8_WAIT_V(6); PG8_BAR; PG8_MMA(1, 1, At, B1); PG8_BAR;
            }
        }
        if constexpr (ALIGN_EPI) { if (wr == 0) PG8_BAR; }
        if constexpr (!Epi::AFTER_DRAIN) { E(acc, cur, wr, wc, fr, fq); S.done(cur); }
        if (!has_next) break;
#pragma unroll
        for (int a = 0; a < 2; ++a)
#pragma unroll
            for (int b = 0; b < 2; ++b)
#pragma unroll
                for (int m = 0; m < 4; ++m)
#pragma unroll
                    for (int n = 0; n < 2; ++n) acc[a][b][m][n] = (f32x4){0.f, 0.f, 0.f, 0.f};
        cur = nxt; cA = nA; cB = nB; ++ui;
        if constexpr (ALIGN_EPI) { if (wr == 1) PG8_BAR; }
    }
    PG8_WAIT_V(0);
    if constexpr (!ALIGN_EPI) { if (wr == 0) PG8_BAR; }
    PG8_BAR;
    if constexpr (Epi::AFTER_DRAIN) { E.fused(acc, cur, wr, wc, fr, fq, lds, wid, lane); S.done(cur); }
#undef PG8_SA
#undef PG8_SB
#undef PG8_STAGE
#undef PG8_LDA
#undef PG8_LDB
#undef PG8_MMA
#undef PG8_WAIT_V
#undef PG8_WAIT_L
#undef PG8_BAR
#undef PG8_SCHED
}
}

constexpr int NWAVES = 8;
constexpr int D = 1024, NB = 8, SEQ = 4096, CTXL = 256, T = NB * SEQ, TC = NB * CTXL, ROWS = T + TC;
constexpr int FF = 2816, NPROJ = 2840, NPROJ_PAD = 3072, KOUT = 1280, NMOD = 9 * D;
constexpr float EPS = 1e-6f;
constexpr int PC_U = 0, PC_Z = 256, PC_XBC = 1024, PROJ_LD = 2816;
constexpr size_t MiB = 1u << 20;
constexpr size_t WS_CTL = 0, CTL_ZERO_BYTES = 1 * MiB;
constexpr size_t WS_MOD = 65536;
constexpr size_t WS_WGU1 = 1 * MiB, WS_WD1 = 12 * MiB, WS_WGU2 = 18 * MiB, WS_WD2 = 29 * MiB, WS_WIN = 35 * MiB, WS_WOUT = 41 * MiB;
constexpr size_t WS_DT = 44 * MiB;
constexpr size_t WS_R1 = 49 * MiB;
constexpr size_t WS_R3 = 236 * MiB;
constexpr size_t WS_R4 = 355 * MiB;
constexpr size_t WS_R5 = 403 * MiB;
constexpr size_t WS_END = 507 * MiB;
constexpr int CW_BAR = 4096;

constexpr int RING_OFF = 0, RING_BYTES = 131072;
constexpr int LDSCTL_OFF = 145408, MISC_OFF = LDSCTL_OFF + 320, TRIG_OFF = LDSCTL_OFF + 1024;
constexpr int LDS_BYTES = 147456;

#define GAS __attribute__((address_space(1)))
#define LAS __attribute__((address_space(3)))
typedef unsigned short bf16;
typedef unsigned v4u __attribute__((ext_vector_type(4)));
typedef unsigned v2u __attribute__((ext_vector_type(2)));
typedef float f32x4 __attribute__((ext_vector_type(4)));
typedef GAS unsigned gu32;
#define LDS_WAIT() asm volatile("s_waitcnt lgkmcnt(0)" ::: "memory")
__device__ __forceinline__ unsigned f2bf(float f) { unsigned u = __builtin_bit_cast(unsigned, f); return (u + 0x7fffu + ((u >> 16) & 1u)) >> 16; }
__device__ __forceinline__ unsigned pk2(float lo, float hi) { return f2bf(lo) | (f2bf(hi) << 16); }
__device__ __forceinline__ float bflo(unsigned w) { return __uint_as_float(w << 16); }
__device__ __forceinline__ float bfhi(unsigned w) { return __uint_as_float(w & 0xffff0000u); }
__device__ __forceinline__ float bf2f(bf16 b) { return __uint_as_float((unsigned)b << 16); }
__device__ __forceinline__ float silu(float g) { return g / (1.0f + __expf(-g)); }
__device__ __forceinline__ float softplus(float v) { return fmaxf(v, 0.f) + log1pf(__expf(-fabsf(v))); }
__device__ __forceinline__ float wave_sum(float v) {
#pragma unroll
    for (int o = 1; o < 64; o <<= 1) v += __shfl_xor(v, o);
    return v;
}

#define XB_TMO      128
#define XB_XCNT(j)  (256  + 64 * (j))
#define XB_XSUB(j)  (1280 + 64 * (j))
#define XB_XGEN(j)  (2304 + 64 * (j))
#define XB_TOP      3328
#define XB_TOPGEN   3392
#define XCD_BAR_WORDS 3456
#define XB_SPIN_CAP (1u << 28)

__device__ __forceinline__ unsigned xb_ld(unsigned* p)              { return __hip_atomic_load(p, __ATOMIC_RELAXED, __HIP_MEMORY_SCOPE_AGENT); }
__device__ __forceinline__ unsigned xb_add(unsigned* p, unsigned v) { return __hip_atomic_fetch_add(p, v, __ATOMIC_RELAXED, __HIP_MEMORY_SCOPE_AGENT); }
__device__ __forceinline__ unsigned xb_xcc_id() { return (unsigned)__builtin_amdgcn_s_getreg((3 << 11) | 20) & 0xFu; }
#define XB_SPIN(cond, bar) do { unsigned _sp = 0; while (cond) { __builtin_amdgcn_s_sleep(1); \
    if ((++_sp & 255u) == 0u) { if (xb_ld(&(bar)[XB_TMO])) break; if (_sp > XB_SPIN_CAP) { atomicAdd(&(bar)[XB_TMO], 1u); break; } } } } while (0)

struct XcdBarrier {
    unsigned* bar; unsigned x;
    volatile LAS unsigned* st;
};

__device__ __forceinline__ XcdBarrier xcd_barrier_post(unsigned* bar, volatile LAS unsigned* st) {
    XcdBarrier b; b.bar = bar; b.x = xb_xcc_id(); b.st = st;
    if (threadIdx.x == 0) (void)xb_add(&bar[XB_XCNT(b.x)], 1u);
    return b;
}
__device__ __forceinline__ void xcd_barrier_complete(unsigned* bar, unsigned x, unsigned& nloc, unsigned& nx) {
    const unsigned G = gridDim.x * gridDim.y * gridDim.z;
    unsigned sum, cnt, mine, sp = 0u;
    for (;;) {
        sum = 0u; cnt = 0u; mine = 0u;
#pragma unroll
        for (unsigned j = 0; j < 16; ++j) { const unsigned c = xb_ld(&bar[XB_XCNT(j)]); sum += c; cnt += (c > 0u) ? 1u : 0u; mine = (j == x) ? c : mine; }
        if (sum == G) break;
        __builtin_amdgcn_s_sleep(1);
        if ((++sp & 255u) == 0u) { if (xb_ld(&bar[XB_TMO])) break; if (sp > XB_SPIN_CAP) { atomicAdd(&bar[XB_TMO], 1u); break; } }
    }
    nloc = mine > 0u ? mine : 1u; nx = cnt > 0u ? cnt : 1u;
}

__device__ __forceinline__ void xcd_barrier(const XcdBarrier& b) {
    asm volatile("s_waitcnt vmcnt(0)" ::: "memory");
    __syncthreads();
    if (threadIdx.x == 0) {
        unsigned* bar = b.bar;
        __builtin_amdgcn_s_waitcnt(0);
        unsigned nloc = b.st[0], nx = b.st[1];
        if (nloc == 0u) { xcd_barrier_complete(bar, b.x, nloc, nx); b.st[0] = nloc; b.st[1] = nx; }
        const unsigned old = xb_add(&bar[XB_XSUB(b.x)], 1u);
        const unsigned gen = old / nloc;
        if (old + 1u == (gen + 1u) * nloc) {
            __builtin_amdgcn_fence(__ATOMIC_RELEASE, "agent");
            asm volatile("s_waitcnt vmcnt(0)" ::: "memory");
            const unsigned og = xb_add(&bar[XB_TOP], 1u);
            const unsigned tg = og / nx;
            if (og + 1u == (tg + 1u) * nx) xb_add(&bar[XB_TOPGEN], 1u);
            else XB_SPIN(xb_ld(&bar[XB_TOPGEN]) == tg, bar);
            __builtin_amdgcn_fence(__ATOMIC_ACQUIRE, "agent");
            xb_add(&bar[XB_XGEN(b.x)], 1u);
            asm volatile("s_waitcnt vmcnt(0)" ::: "memory");
        } else {
            XB_SPIN(xb_ld(&bar[XB_XGEN(b.x)]) == gen, bar);
            __builtin_amdgcn_fence(__ATOMIC_ACQUIRE, "agent");
            asm volatile("s_waitcnt vmcnt(0)" ::: "memory");
        }
    }
    __syncthreads();
}


struct Args { const float* in[27]; float* out; unsigned char* ws; };
enum { I_X = 0, I_C, I_CTX, I_CCTX, I_ADAW, I_ADAB, I_F1PRE, I_F1POST, I_F1G, I_F1U, I_F1D, I_MPRE, I_MPOST, I_WIN, I_FW, I_CONVW, I_CONVB, I_DTB, I_ALOG, I_DSKIP, I_SSDN, I_WOUT,
       I_F2PRE, I_F2POST, I_F2G, I_F2U, I_F2D };

struct Frame {
    LAS unsigned char* lds;
    int tid, lane, wave, vcu, G, gw, NGW;
    const Args* a;
};

constexpr int TS = 272;
constexpr int NSLOT = 34;
typedef short bf16x8 __attribute__((ext_vector_type(8)));
#define MFMA16(a, b, c) __builtin_amdgcn_mfma_f32_16x16x32_bf16(a, b, c, 0, 0, 0)
__device__ __forceinline__ bf16x8 lds_frag(const LAS unsigned char* tile, int row0, int ks, int lane) {
    return *(const LAS bf16x8*)(tile + (row0 + (lane & 15)) * TS + (32 * ks + 8 * (lane >> 4)) * 2);
}
__device__ __forceinline__ void tile_copy(LAS unsigned char* tile, const bf16* src, int sld, int nrows, int tid) {
    for (int i = tid; i < nrows * 16; i += NWAVES * 64) { const int r = i >> 4, c = i & 15; *(LAS v4u*)(tile + r * TS + c * 16) = *(const v4u*)(src + (size_t)r * sld + c * 8); }
}
__device__ __forceinline__ void tr8x8_load(const bf16* src, int sld, v4u (&v)[8]) {
#pragma unroll
    for (int k = 0; k < 8; ++k) v[k] = *(const v4u*)(src + (size_t)k * sld);
}
__device__ __forceinline__ void tr8x8_store(const v4u (&v)[8], LAS unsigned char* dst) {
#pragma unroll
    for (int i = 0; i < 8; ++i) { const int wi = i >> 1, sh = (i & 1) * 16; v4u o;
        o.x = ((v[0][wi] >> sh) & 0xffffu) | (((v[1][wi] >> sh) & 0xffffu) << 16); o.y = ((v[2][wi] >> sh) & 0xffffu) | (((v[3][wi] >> sh) & 0xffffu) << 16);
        o.z = ((v[4][wi] >> sh) & 0xffffu) | (((v[5][wi] >> sh) & 0xffffu) << 16); o.w = ((v[6][wi] >> sh) & 0xffffu) | (((v[7][wi] >> sh) & 0xffffu) << 16);
        *(LAS v4u*)(dst + i * TS) = o; }
}
__device__ __forceinline__ float bfsel(unsigned w, int hi) { return hi ? bfhi(w) : bflo(w); }
__device__ __forceinline__ void tr8x8_store_scaled(const v4u (&v)[8], const float (&s)[8], LAS unsigned char* dst) {
#pragma unroll
    for (int i = 0; i < 8; ++i) { const int wi = i >> 1, hi = i & 1; v4u o;
        o.x = pk2(bfsel(v[0][wi], hi) * s[0], bfsel(v[1][wi], hi) * s[1]); o.y = pk2(bfsel(v[2][wi], hi) * s[2], bfsel(v[3][wi], hi) * s[3]);
        o.z = pk2(bfsel(v[4][wi], hi) * s[4], bfsel(v[5][wi], hi) * s[5]); o.w = pk2(bfsel(v[6][wi], hi) * s[6], bfsel(v[7][wi], hi) * s[7]);
        *(LAS v4u*)(dst + i * TS) = o; }
}
struct SsdBufs {
    const bf16* XC;
    const float* dtraw;
    float* DTV; float* ACU;
    float* DEC;
    bf16* S;
    const bf16* Zg;
    bf16* A4;
    const float* dtb; const float* alog; const float* dskip; const float* ssdn;
};
__device__ __forceinline__ void unit_decode(int u, int& b, int& g, int& slot, int& rbase) {
    if (u < 1024) { b = u >> 7; const int c = (u >> 2) & 31; g = u & 3; slot = 2 + c; rbase = b * SEQ + 128 * c; }
    else { const int j = u - 1024; b = j >> 3; const int cc = (j >> 2) & 1; g = j & 3; slot = cc; rbase = T + b * CTXL + 128 * cc; }
}

__device__ __forceinline__ void ssd_states_unit(const SsdBufs& Q, LAS unsigned char* L, int u, int tid, int wave, int lane) {
    int b, g, slot, rbase; unit_decode(u, b, g, slot, rbase);
    LAS unsigned char* BT = L;
    LAS unsigned char* XW = L + 128 * TS;
    LAS float* wts = (LAS float*)(L + 128 * TS + 6 * 64 * TS);
    LAS float* dAs = wts + 768;
    for (int t = tid; t < 768; t += NWAVES * 64) { const int hd = t >> 7, s = t & 127, dir = hd / 3, hh = 3 * g + hd % 3;
        const float dtv = softplus(Q.dtraw[(size_t)(rbase + s) * 32 + dir * 12 + hh] + Q.dtb[dir * 12 + hh]);
        dAs[t] = dtv * (-__expf(Q.alog[dir * 12 + hh])); wts[t] = dtv; }
    __syncthreads();
    if (wave < 6) { const int hd = wave, dir = hd / 3, hh = 3 * g + hd % 3;
        const int s0 = dir ? 127 - 2 * lane : 2 * lane, s1 = dir ? 126 - 2 * lane : 2 * lane + 1;
        const float a0 = dAs[hd * 128 + s0], a1 = dAs[hd * 128 + s1], pr = a0 + a1; float incl = pr;
#pragma unroll
        for (int o = 1; o < 64; o <<= 1) { const float t = __shfl_up(incl, o); if (lane >= o) incl += t; }
        const float A0 = incl - pr + a0, A1 = incl, tot = __shfl(incl, 63);
        const float d0 = wts[hd * 128 + s0], d1 = wts[hd * 128 + s1];
        const size_t gi = (size_t)(dir * 12 + hh) * ROWS + rbase;
        Q.ACU[gi + s0] = A0; Q.ACU[gi + s1] = A1; Q.DTV[gi + s0] = d0; Q.DTV[gi + s1] = d1;
        wts[hd * 128 + s0] = __expf(tot - A0) * d0; wts[hd * 128 + s1] = __expf(tot - A1) * d1;
        if (lane == 0) Q.DEC[((size_t)(dir * NB + b) * NSLOT + slot) * 12 + hh] = __expf(tot); }
    __syncthreads();
    for (int it = tid; it < 640; it += NWAVES * 64) {
        v4u v[8];
        if (it < 256) { const int cv = it & 15, rb = it >> 4;
            tr8x8_load(Q.XC + (size_t)(rbase + 8 * rb) * 1792 + 1280 + g * 128 + 8 * cv, 1792, v);
            tr8x8_store(v, BT + (8 * cv) * TS + (8 * rb) * 2); }
        else { const int j = it - 256, cv = j % 24, rb = j / 24, hl = cv >> 3, p0 = (8 * cv) & 63;
            tr8x8_load(Q.XC + (size_t)(rbase + 8 * rb) * 1792 + 512 + g * 192 + 8 * cv, 1792, v);
#pragma unroll
            for (int dir = 0; dir < 2; ++dir) { const int hd = dir * 3 + hl; float s[8];
#pragma unroll
                for (int k = 0; k < 8; ++k) s[k] = wts[hd * 128 + 8 * rb + k];
                tr8x8_store_scaled(v, s, XW + (hd * 64 + p0) * TS + (8 * rb) * 2); } }
    }
    __syncthreads();
    f32x4 acc[6][4];
#pragma unroll
    for (int hd = 0; hd < 6; ++hd)
#pragma unroll
        for (int pb = 0; pb < 4; ++pb) acc[hd][pb] = (f32x4){0.f, 0.f, 0.f, 0.f};
#pragma unroll
    for (int ks = 0; ks < 4; ++ks) { const bf16x8 bfr = lds_frag(BT, 16 * wave, ks, lane);
#pragma unroll
        for (int hd = 0; hd < 6; ++hd)
#pragma unroll
            for (int pb = 0; pb < 4; ++pb) acc[hd][pb] = MFMA16(bfr, lds_frag(XW, hd * 64 + 16 * pb, ks, lane), acc[hd][pb]); }
    const int n0 = 16 * wave + 4 * (lane >> 4), pl = lane & 15;
#pragma unroll
    for (int hd = 0; hd < 6; ++hd) { const int dir = hd / 3, hh = 3 * g + hd % 3;
        bf16* sp = Q.S + ((((size_t)(dir * NB + b) * NSLOT + slot) * 12 + hh) * 64) * 128;
#pragma unroll
        for (int pb = 0; pb < 4; ++pb) { v2u w; w.x = pk2(acc[hd][pb][0], acc[hd][pb][1]); w.y = pk2(acc[hd][pb][2], acc[hd][pb][3]);
            *(GAS v2u*)(sp + (size_t)(16 * pb + pl) * 128 + n0) = w; } }
    __syncthreads();
}

template <int DIR>
__device__ __forceinline__ void ssd_scan_item(const SsdBufs& Q, int b, int hh, int pv) {
    bf16* base = Q.S + (((size_t)(DIR * NB + b) * NSLOT) * 12 + hh) * 8192 + (size_t)pv * 8;
    const float* dec = Q.DEC + ((size_t)(DIR * NB + b) * NSLOT) * 12 + hh;
    constexpr size_t SL = (size_t)12 * 8192;
    v4u sv[NSLOT];
#pragma unroll
    for (int i = 0; i < NSLOT; ++i) { const int slot = DIR == 0 ? i : (i < 2 ? 1 - i : NSLOT + 1 - i); sv[i] = *(const v4u*)(base + slot * SL); }
    float h[8];
#pragma unroll
    for (int k = 0; k < 8; ++k) h[k] = 0.f;
#pragma unroll
    for (int i = 0; i < NSLOT; ++i) { const int slot = DIR == 0 ? i : (i < 2 ? 1 - i : NSLOT + 1 - i);
        v4u o; o.x = pk2(h[0], h[1]); o.y = pk2(h[2], h[3]); o.z = pk2(h[4], h[5]); o.w = pk2(h[6], h[7]);
        *(GAS v4u*)(base + slot * SL) = o;
        const float d = dec[slot * 12];
        h[0] = d * h[0] + bflo(sv[i].x); h[1] = d * h[1] + bfhi(sv[i].x); h[2] = d * h[2] + bflo(sv[i].y); h[3] = d * h[3] + bfhi(sv[i].y);
        h[4] = d * h[4] + bflo(sv[i].z); h[5] = d * h[5] + bfhi(sv[i].z); h[6] = d * h[6] + bflo(sv[i].w); h[7] = d * h[7] + bfhi(sv[i].w); }
}

__device__ __forceinline__ void ssd_out_unit(const SsdBufs& Q, LAS unsigned char* L, int u, int tid, int wave, int lane) {
    int b, g, slot, rbase; unit_decode(u, b, g, slot, rbase);
    LAS unsigned char* Cs = L;
    LAS unsigned char* BM = L + 128 * TS;
    LAS unsigned char* XT = L + 256 * TS;
    LAS unsigned char* HF = L + 320 * TS;
    LAS unsigned char* HB = L + 384 * TS;
    LAS float* AR = (LAS float*)(L + 448 * TS);
    tile_copy(Cs, Q.XC + (size_t)rbase * 1792 + g * 128, 1792, 128, tid);
    tile_copy(BM, Q.XC + (size_t)rbase * 1792 + 1280 + g * 128, 1792, 128, tid);
    for (int t = tid; t < 1536; t += NWAVES * 64) { const int hl = t / 512, q = (t >> 7) & 3, s = t & 127, dir = q & 1, hh = 3 * g + hl;
        const float* src = (q < 2 ? Q.ACU : Q.DTV) + (size_t)(dir * 12 + hh) * ROWS + rbase + s; AR[t] = *src; }
    __syncthreads();
    f32x4 gt[8];
#pragma unroll
    for (int sb = 0; sb < 8; ++sb) gt[sb] = (f32x4){0.f, 0.f, 0.f, 0.f};
#pragma unroll
    for (int ks = 0; ks < 4; ++ks) { const bf16x8 cfr = lds_frag(Cs, 16 * wave, ks, lane);
#pragma unroll
        for (int sb = 0; sb < 8; ++sb) gt[sb] = MFMA16(lds_frag(BM, 16 * sb, ks, lane), cfr, gt[sb]); }
    const int ll = 16 * wave + (lane & 15), q4 = 4 * (lane >> 4);
    float ss = 0.f;
    bf16* orow = Q.A4 + ((size_t)rbase + ll) * KOUT + 512 + g * 192;
#pragma unroll 1
    for (int hl = 0; hl < 3; ++hl) {
        const int hh = 3 * g + hl;
        __syncthreads();
        for (int it = tid; it < 128; it += NWAVES * 64) { const int cv = it & 7, rb = it >> 3; v4u v[8];
            tr8x8_load(Q.XC + (size_t)(rbase + 8 * rb) * 1792 + 512 + hh * 64 + 8 * cv, 1792, v);
            tr8x8_store(v, XT + (8 * cv) * TS + (8 * rb) * 2); }
        tile_copy(HF, Q.S + ((((size_t)(0 * NB + b) * NSLOT + slot) * 12 + hh) * 64) * 128, 128, 64, tid);
        tile_copy(HB, Q.S + ((((size_t)(1 * NB + b) * NSLOT + slot) * 12 + hh) * 64) * 128, 128, 64, tid);
        { const LAS float* Af = AR + hl * 512, * Ab = Af + 128, * df = Af + 256, * db = Af + 384;
          const float afl = Af[ll], abl = Ab[ll];
#pragma unroll
          for (int sb = 0; sb < 8; ++sb) { float m[4];
#pragma unroll
              for (int r = 0; r < 4; ++r) { const int s = 16 * sb + q4 + r;
                  const float wf = (s <= ll) ? __expf(afl - Af[s]) * df[s] : 0.f, wb = (s >= ll) ? __expf(abl - Ab[s]) * db[s] : 0.f;
                  m[r] = gt[sb][r] * (wf + wb); }
              v2u w; w.x = pk2(m[0], m[1]); w.y = pk2(m[2], m[3]);
              *(LAS v2u*)(BM + ll * TS + (16 * sb + q4) * 2) = w; asm volatile("" ::: "memory"); } }
        __syncthreads();
        f32x4 aD[4], aF[4], aB[4];
#pragma unroll
        for (int pb = 0; pb < 4; ++pb) { aD[pb] = (f32x4){0.f, 0.f, 0.f, 0.f}; aF[pb] = aD[pb]; aB[pb] = aD[pb]; }
#pragma unroll
        for (int ks = 0; ks < 4; ++ks) { const bf16x8 mfr = lds_frag(BM, 16 * wave, ks, lane), cfr = lds_frag(Cs, 16 * wave, ks, lane);
#pragma unroll
            for (int pb = 0; pb < 4; ++pb) { aD[pb] = MFMA16(lds_frag(XT, 16 * pb, ks, lane), mfr, aD[pb]);
                aF[pb] = MFMA16(lds_frag(HF, 16 * pb, ks, lane), cfr, aF[pb]); aB[pb] = MFMA16(lds_frag(HB, 16 * pb, ks, lane), cfr, aB[pb]); } }
        const float eaf = __expf(AR[hl * 512 + ll]), eab = __expf(AR[hl * 512 + 128 + ll]), dsk = Q.dskip[hh];
        const size_t row = (size_t)rbase + ll;
#pragma unroll
        for (int pb = 0; pb < 4; ++pb) { const int p = 16 * pb + q4;
            const v2u xw = *(const v2u*)(Q.XC + row * 1792 + 512 + hh * 64 + p), zw = *(const v2u*)(Q.Zg + row * 768 + hh * 64 + p);
            const float xs[4] = {bflo(xw.x), bfhi(xw.x), bflo(xw.y), bfhi(xw.y)}, zs[4] = {bflo(zw.x), bfhi(zw.x), bflo(zw.y), bfhi(zw.y)};
            float y[4];
#pragma unroll
            for (int r = 0; r < 4; ++r) { y[r] = (aD[pb][r] + eaf * aF[pb][r] + eab * aB[pb][r] + dsk * xs[r]) * silu(zs[r]);
                y[r] = __uint_as_float(f2bf(y[r]) << 16); ss += y[r] * y[r]; }
            v2u w; w.x = pk2(y[0], y[1]); w.y = pk2(y[2], y[3]);
            *(GAS v2u*)(orow + hl * 64 + p) = w; }
    }
    ss += __shfl_xor(ss, 16); ss += __shfl_xor(ss, 32);
    const float rs = 1.0f / sqrtf(ss * (1.0f / 192.0f) + EPS);
#pragma unroll 1
    for (int hl = 0; hl < 3; ++hl)
#pragma unroll
        for (int pb = 0; pb < 4; ++pb) { const int c = hl * 64 + 16 * pb + q4; const f32x4 gn = *(const f32x4*)(Q.ssdn + g * 192 + c);
            const v2u yw = *(const GAS v2u*)(orow + c);
            v2u w; w.x = pk2(bflo(yw.x) * rs * gn[0], bfhi(yw.x) * rs * gn[1]); w.y = pk2(bflo(yw.y) * rs * gn[2], bfhi(yw.y) * rs * gn[3]);
            *(GAS v2u*)(orow + c) = w; }
    __syncthreads();
}


__device__ __forceinline__ void transpose_item(const float* W, int K, int N, bf16* WT, int dstld, int koff, int mode, LAS float* scr, int item, int lane) {
    const int nblk = (N + 31) / 32, kb = item / nblk, nb = item % nblk, k0 = 64 * kb, n0 = 32 * nb;
    const int nn = n0 + (lane & 31);
#pragma unroll 8
    for (int i = 0; i < 32; ++i) { const int kk = 2 * i + (lane >> 5); scr[kk * 33 + (lane & 31)] = (nn < N) ? W[(size_t)(k0 + kk) * N + nn] : 0.f; }
    LDS_WAIT(); asm volatile("" ::: "memory");
    const int c = lane & 7;
#pragma unroll
    for (int j = 0; j < 4; ++j) { const int nl = (lane >> 3) + 8 * j, n = n0 + nl; const LAS float* s = scr + (8 * c) * 33 + nl;
        v4u o; o.x = pk2(s[0 * 33], s[1 * 33]); o.y = pk2(s[2 * 33], s[3 * 33]); o.z = pk2(s[4 * 33], s[5 * 33]); o.w = pk2(s[6 * 33], s[7 * 33]);
        const int row = (mode == 0) ? n : (256 * (n >> 7) + (n & 127) + (mode == 2 ? 128 : 0));
        if (n < N) *(GAS v4u*)(WT + (size_t)row * dstld + koff + k0 + 8 * c) = o; }
    LDS_WAIT(); asm volatile("" ::: "memory");
}

__device__ __forceinline__ void fold_item(const float* fw, const float* wout, bf16* WoT, const LAS float* trig, int item, int lane) {
    const int nq = item & 3, dblk = (item >> 2) & 7, cs = (item >> 5) & 1, h = item >> 6;
    float t[8];
#pragma unroll
    for (int j = 0; j < 8; ++j) t[j] = 0.f;
    for (int m = 0; m < 64; ++m) { const float f = fw[(h * 64 + m) * 64 + lane];
#pragma unroll
        for (int j = 0; j < 8; ++j) { const int d = 8 * dblk + j; t[j] += trig[cs * 64 + ((d * m) & 63)] * f; } }
    f32x4 acc[8];
#pragma unroll
    for (int j = 0; j < 8; ++j) { t[j] *= (1.0f / 512.0f); acc[j] = (f32x4){0.f, 0.f, 0.f, 0.f}; }
    const int n = nq * 256 + lane * 4;
    for (int e = 0; e < 64; ++e) { const f32x4 w = *(const f32x4*)(wout + (size_t)(64 * h + e) * D + n);
#pragma unroll
        for (int j = 0; j < 8; ++j) { const float tj = __shfl(t[j], e); acc[j] += w * tj; } }
#pragma unroll
    for (int q = 0; q < 4; ++q) { v4u o; o.x = pk2(acc[0][q], acc[1][q]); o.y = pk2(acc[2][q], acc[3][q]); o.z = pk2(acc[4][q], acc[5][q]); o.w = pk2(acc[6][q], acc[7][q]);
        *(GAS v4u*)(WoT + (size_t)(n + q) * KOUT + cs * 256 + 64 * h + 8 * dblk) = o; }
}

__device__ __forceinline__ void mod_item_wg(const float* adaw, const float* adab, float* mod, const LAS float* sc, LAS float* red, int item, int wave, int lane, int tid) {
    const int kq = lane >> 4, c4 = lane & 15, col = item * 64 + 4 * c4;
    f32x4 acc[9];
#pragma unroll
    for (int r = 0; r < 9; ++r) acc[r] = (f32x4){0.f, 0.f, 0.f, 0.f};
#pragma unroll 8
    for (int s = 0; s < 32; ++s) { const int row = 128 * wave + 4 * s + kq; const f32x4 w = *(const f32x4*)(adaw + (size_t)row * NMOD + col);
#pragma unroll
        for (int r = 0; r < 9; ++r) acc[r] += w * sc[r * D + row]; }
#pragma unroll
    for (int r = 0; r < 9; ++r)
#pragma unroll
        for (int q = 0; q < 4; ++q) { float v = acc[r][q]; v += __shfl_xor(v, 16); v += __shfl_xor(v, 32); if (kq == 0) red[(wave * 9 + r) * 64 + 4 * c4 + q] = v; }
    __syncthreads();
    for (int o = tid; o < 9 * 64; o += NWAVES * 64) { const int r = o >> 6, c = o & 63; float v = adab[item * 64 + c];
#pragma unroll
        for (int w = 0; w < NWAVES; ++w) v += red[(w * 9 + r) * 64 + c];
        mod[r * NMOD + item * 64 + c] = v; }
}

__device__ __forceinline__ void row_load(const float* p, int lane, f32x4 (&v)[4]) {
#pragma unroll
    for (int j = 0; j < 4; ++j) v[j] = *(const f32x4*)(p + 4 * (lane + 64 * j));
}
__device__ __forceinline__ float row_sumsq(const f32x4 (&v)[4]) {
    float s = 0.f;
#pragma unroll
    for (int j = 0; j < 4; ++j) s += (v[j][0] * v[j][0] + v[j][1] * v[j][1]) + (v[j][2] * v[j][2] + v[j][3] * v[j][3]);
    return wave_sum(s);
}
__device__ __forceinline__ void row_mod_store(const f32x4 (&v)[4], float rstd, const float* g, const float* shift, const float* scale, bf16* orow, int lane) {
#pragma unroll
    for (int j = 0; j < 4; ++j) { const int c = 4 * (lane + 64 * j);
        const f32x4 gg = *(const f32x4*)(g + c), sh = *(const f32x4*)(shift + c), sc = *(const f32x4*)(scale + c);
        const f32x4 o = (v[j] * rstd * gg) * (sc + 1.0f) + sh;
        v2u w; w.x = pk2(o[0], o[1]); w.y = pk2(o[2], o[3]);
        *(GAS v2u*)(orow + c) = w; }
}
__device__ __forceinline__ void row_residual(f32x4 (&v)[4], const float* yrow, const float* base, const float* gpost, const float* gate, float gwt, int lane) {
    f32x4 y[4]; row_load(yrow, lane, y);
    const float ry = 1.0f / sqrtf(row_sumsq(y) * (1.0f / D) + EPS);
#pragma unroll
    for (int j = 0; j < 4; ++j) { const int c = 4 * (lane + 64 * j);
        const f32x4 b = *(const f32x4*)(base + c), gp = *(const f32x4*)(gpost + c), gt = *(const f32x4*)(gate + c);
        v[j] = b + gt * gwt * (y[j] * ry * gp); }
}
__device__ __forceinline__ void row_store(float* p, int lane, const f32x4 (&v)[4]) {
#pragma unroll
    for (int j = 0; j < 4; ++j) *(f32x4*)(p + 4 * (lane + 64 * j)) = v[j];
}


#define DBG_HASHED 0
#ifndef DBG_STAGE
#define DBG_STAGE 0
#endif
__device__ __forceinline__ float dbg_hash(float v) { unsigned u = __float_as_uint(v); u *= 2654435761u; u ^= u >> 15; u *= 2246822519u; u ^= u >> 13; return (float)((int)(u & 0xffffu) - 32768) * (1.0f / 32.0f); }
#define DBG_DUMP(stage, expr) do { if (DBG_STAGE == (stage)) { for (size_t i_ = (size_t)gw * 64 + lane; i_ < (size_t)T * D; i_ += (size_t)NGW * 64) { const size_t row_ = i_ >> 10, col_ = i_ & 1023; OUT[i_] = DBG_HASHED ? dbg_hash(expr) : (expr); } return; } } while (0)
__global__ void __launch_bounds__(NWAVES * 64, 2) mk_fwd(Args args) {
    extern __shared__ __attribute__((aligned(16))) unsigned char lds_raw[];
    Frame F;
    F.lds = (LAS unsigned char*)lds_raw;
    F.tid = threadIdx.x; F.lane = F.tid & 63; F.wave = __builtin_amdgcn_readfirstlane(F.tid >> 6);
    F.G = gridDim.x; { const int bx = blockIdx.x; F.vcu = (F.G % 8 == 0) ? (bx % 8) * (F.G / 8) + bx / 8 : bx; }
    F.gw = F.vcu * NWAVES + F.wave; F.NGW = F.G * NWAVES;
    const int lane = F.lane, gw = F.gw, NGW = F.NGW;
    unsigned char* ws = args.ws;
    const float* const* in = args.in;
    gu32* ctl = (gu32*)(ws + WS_CTL);
    float* mod = (float*)(ws + WS_MOD);
    bf16* Wgu1 = (bf16*)(ws + WS_WGU1); bf16* Wd1 = (bf16*)(ws + WS_WD1); bf16* Wgu2 = (bf16*)(ws + WS_WGU2); bf16* Wd2 = (bf16*)(ws + WS_WD2);
    bf16* Win = (bf16*)(ws + WS_WIN); bf16* WoT = (bf16*)(ws + WS_WOUT);
    float* dtraw = (float*)(ws + WS_DT);
    bf16* Hb = (bf16*)(ws + WS_R5);
    bf16* ACT = (bf16*)(ws + WS_R1);
    bf16* XBR = (bf16*)(ws + WS_R1);
    bf16* Ub = (bf16*)(ws + WS_R1 + 119 * MiB);
    bf16* Zr16 = (bf16*)(ws + WS_R1 + 135 * MiB); bf16* Zi16 = (bf16*)(ws + WS_R1 + 151 * MiB);
    float* DTV = (float*)(ws + WS_R1 + 167 * MiB); float* ACU = (float*)(ws + WS_R1 + 171 * MiB); float* DEC = (float*)(ws + WS_R1 + 175 * MiB);
    bf16* XC = (bf16*)(ws + WS_R3);
    bf16* Zg = (bf16*)(ws + WS_R4);
    bf16* Sb = (bf16*)(ws + WS_R5);
    float* Y1 = (float*)(ws + WS_R3);
    float* Y2 = (float*)(ws + WS_R3);
    float* Y3 = (float*)(ws + WS_R3);
    bf16* A4 = (bf16*)(ws + WS_R1);
    float* OUT = args.out;

    for (int u = F.tid; u < (LDS_BYTES - LDSCTL_OFF) / 4; u += NWAVES * 64) ((LAS unsigned*)(F.lds + LDSCTL_OFF))[u] = 0u;
    __syncthreads();
    LAS float* trig = (LAS float*)(F.lds + TRIG_OFF);
    if (F.tid < 64) { trig[F.tid] = cospif((float)F.tid / 32.0f); trig[64 + F.tid] = sinpif((float)F.tid / 32.0f); }
    XcdBarrier bar = xcd_barrier_post((unsigned*)(ctl + CW_BAR), (volatile LAS unsigned*)(F.lds + MISC_OFF) + 8);
    __syncthreads();

    {
        LAS float* sc = (LAS float*)(F.lds + RING_OFF);
        for (int i = F.tid; i < 9 * D; i += NWAVES * 64) { const int r = i >> 10, k = i & 1023; const float v = (r < 8) ? in[I_C][r * D + k] : in[I_CCTX][k]; sc[i] = silu(v); }
        __syncthreads();
        LAS float* scr = (LAS float*)(F.lds + RING_OFF + 40960 + F.wave * 8448);
        if (F.vcu < 144) mod_item_wg(in[I_ADAW], in[I_ADAB], mod, sc, (LAS float*)(F.lds + RING_OFF + 110592), F.vcu, F.wave, lane, F.tid);
        constexpr int I_FOLD = 256, I_MODN = 0, I_GU = 16 * 88, I_DN = 44 * 32, I_WINN = 16 * 89, I_WO = 12 * 32;
        constexpr int NITEMS = I_FOLD + I_MODN + 2 * (2 * I_GU + I_DN) + I_WINN + I_WO;
        for (int it = gw; it < NITEMS; it += NGW) {
            int r = it;
            if (r < I_FOLD) { fold_item(in[I_FW], in[I_WOUT], WoT, trig, r, lane); continue; } r -= I_FOLD;
            if (r < I_GU) { transpose_item(in[I_F1G], D, FF, Wgu1, D, 0, 1, scr, r, lane); continue; } r -= I_GU;
            if (r < I_GU) { transpose_item(in[I_F1U], D, FF, Wgu1, D, 0, 2, scr, r, lane); continue; } r -= I_GU;
            if (r < I_DN) { transpose_item(in[I_F1D], FF, D, Wd1, FF, 0, 0, scr, r, lane); continue; } r -= I_DN;
            if (r < I_GU) { transpose_item(in[I_F2G], D, FF, Wgu2, D, 0, 1, scr, r, lane); continue; } r -= I_GU;
            if (r < I_GU) { transpose_item(in[I_F2U], D, FF, Wgu2, D, 0, 2, scr, r, lane); continue; } r -= I_GU;
            if (r < I_DN) { transpose_item(in[I_F2D], FF, D, Wd2, FF, 0, 0, scr, r, lane); continue; } r -= I_DN;
            if (r < I_WINN) { transpose_item(in[I_WIN], D, NPROJ, Win, D, 0, 0, scr, r, lane); continue; } r -= I_WINN;
            transpose_item(in[I_WOUT] + (size_t)256 * D, 768, D, WoT, KOUT, 512, 0, scr, r, lane);
        }
        { GAS v4u* z = (GAS v4u*)(Win + (size_t)NPROJ * D); const int nz = (NPROJ_PAD - NPROJ) * D / 8;
          for (int i = gw * 64 + lane; i < nz; i += NGW * 64) z[i] = (v4u){0u, 0u, 0u, 0u}; }
    }
    xcd_barrier(bar);

    for (int row = gw; row < ROWS; row += NGW) {
        const float* src = row < T ? in[I_X] + (size_t)row * D : in[I_CTX] + (size_t)(row - T) * D;
        const float* mb = mod + (size_t)(row < T ? (row >> 12) : 8) * NMOD;
        f32x4 v[4]; row_load(src, lane, v);
        const float rs = 1.0f / sqrtf(row_sumsq(v) * (1.0f / D) + EPS);
        row_mod_store(v, rs, in[I_F1PRE], mb + 0 * D, mb + 1 * D, Hb + (size_t)row * D, lane);
    }
    xcd_barrier(bar);
    DBG_DUMP(1, bf2f(Hb[row_ * D + col_]));

    { pg8::Gemm g{Hb, Wgu1, ROWS, 2 * FF, D}; pg8::StaticOrder S; S.init(ROWS, 2 * FF, F.G, (int)blockIdx.x);
      pg8::EpiSwiGLU E{ACT, FF};
      pg8::gemm_phase<pg8::EpiSwiGLU, pg8::StaticOrder, true, true>(F.lds + RING_OFF, g, S, E); }
    xcd_barrier(bar);
    DBG_DUMP(2, bf2f(ACT[row_ * FF + col_]));
    { pg8::Gemm g{ACT, Wd1, ROWS, D, FF}; pg8::StaticOrder S; S.init(ROWS, D, F.G, (int)blockIdx.x);
      pg8::EpiF32 E{Y1, D};
      pg8::gemm_phase<pg8::EpiF32, pg8::StaticOrder, true, true>(F.lds + RING_OFF, g, S, E); }
    xcd_barrier(bar);
    DBG_DUMP(3, Y1[row_ * D + col_]);
    for (int row = gw; row < ROWS; row += NGW) {
        const float* base = row < T ? in[I_X] + (size_t)row * D : in[I_CTX] + (size_t)(row - T) * D;
        const float* mb = mod + (size_t)(row < T ? (row >> 12) : 8) * NMOD;
        f32x4 v[4]; row_residual(v, Y1 + (size_t)row * D, base, in[I_F1POST], mb + 2 * D, 0.5f, lane);
        if (row < T) row_store(OUT + (size_t)row * D, lane, v);
        const float rs = 1.0f / sqrtf(row_sumsq(v) * (1.0f / D) + EPS);
        row_mod_store(v, rs, in[I_MPRE], mb + 3 * D, mb + 4 * D, Hb + (size_t)row * D, lane);
    }
    xcd_barrier(bar);
    DBG_DUMP(4, bf2f(Hb[row_ * D + col_]));
    { pg8::Gemm g{Hb, Win, ROWS, NPROJ_PAD, D}; pg8::StaticOrder S; S.init(ROWS, NPROJ_PAD, F.G, (int)blockIdx.x);
      pg8::EpiProj E{Ub, Zg, XBR, dtraw, T / 256};
      pg8::gemm_phase<pg8::EpiProj, pg8::StaticOrder, true, true>(F.lds + RING_OFF, g, S, E); }
    xcd_barrier(bar);

    const int GT = F.G * NWAVES * 64, gtid = F.vcu * NWAVES * 64 + F.tid;
    SsdBufs Q{XC, dtraw, DTV, ACU, DEC, Sb, Zg, A4, in[I_DTB], in[I_ALOG], in[I_DSKIP], in[I_SSDN]};
    {
        const float* convw = in[I_CONVW]; const float* convb = in[I_CONVB];
        for (int it = gtid; it < (ROWS / 16) * 224; it += GT) {
            const int cv = it % 224, strip = it / 224, row0 = strip * 16, ch = 8 * cv;
            const int l0 = row0 < T ? (row0 & (SEQ - 1)) : ((row0 - T) & (CTXL - 1)), len = row0 < T ? SEQ : CTXL;
            float w0[8], w1[8], w2[8], bb[8];
#pragma unroll
            for (int q = 0; q < 2; ++q) { const f32x4 a = *(const f32x4*)(convw + ch + 4 * q), b1 = *(const f32x4*)(convw + 1792 + ch + 4 * q), c = *(const f32x4*)(convw + 3584 + ch + 4 * q), d = *(const f32x4*)(convb + ch + 4 * q);
#pragma unroll
                for (int e = 0; e < 4; ++e) { w0[4 * q + e] = a[e]; w1[4 * q + e] = b1[e]; w2[4 * q + e] = c[e]; bb[4 * q + e] = d[e]; } }
            const bf16* src = XBR + (size_t)row0 * 1792 + ch; bf16* dst = XC + (size_t)row0 * 1792 + ch;
            v4u prev = (l0 > 0) ? *(const v4u*)(src - 1792) : (v4u){0u, 0u, 0u, 0u}, cur = *(const v4u*)src;
#pragma unroll 4
            for (int r = 0; r < 16; ++r) {
                const v4u nxt = (l0 + r + 1 < len) ? *(const v4u*)(src + (size_t)(r + 1) * 1792) : (v4u){0u, 0u, 0u, 0u};
                float o[8];
#pragma unroll
                for (int e = 0; e < 8; ++e) { const int wi = e >> 1, hi = e & 1; o[e] = silu(bb[e] + w0[e] * bfsel(prev[wi], hi) + w1[e] * bfsel(cur[wi], hi) + w2[e] * bfsel(nxt[wi], hi)); }
                v4u ov; ov.x = pk2(o[0], o[1]); ov.y = pk2(o[2], o[3]); ov.z = pk2(o[4], o[5]); ov.w = pk2(o[6], o[7]);
                *(GAS v4u*)(dst + (size_t)r * 1792) = ov; prev = cur; cur = nxt; }
        }
        for (int idx = gtid; idx < NB * 64 * 64 * 256; idx += GT) {
            const int ch = idx & 255, l2 = (idx >> 8) & 63, k1 = (idx >> 14) & 63, b = idx >> 20;
            float yr = 0.f, yi = 0.f;
            for (int l1 = 0; l1 < 64; ++l1) { const float uv = bf2f(Ub[(size_t)(b * SEQ + 64 * l1 + l2) * 256 + ch]); const int j = (k1 * l1) & 63; yr += trig[j] * uv; yi -= trig[64 + j] * uv; }
            const float ang = (float)(k1 * l2) / 2048.0f, tc = cospif(ang), ts = sinpif(ang);
            Zr16[idx] = (bf16)f2bf(yr * tc + yi * ts); Zi16[idx] = (bf16)f2bf(yi * tc - yr * ts);
        }
    }
    xcd_barrier(bar);
    for (int u = F.vcu; u < 1088; u += F.G) ssd_states_unit(Q, F.lds, u, F.tid, F.wave, lane);
    xcd_barrier(bar);
    {
        for (int it = gtid; it < 2 * NB * 12 * 1024; it += GT) { const int pv = it & 1023, hh = (it >> 10) % 12, b = (it / (1024 * 12)) & 7, dir = it / (1024 * 12 * NB);
            if (dir == 0) ssd_scan_item<0>(Q, b, hh, pv); else ssd_scan_item<1>(Q, b, hh, pv); }
        for (int idx = gtid; idx < NB * 64 * 64 * 256; idx += GT) {
            const int ch = idx & 255, k2 = (idx >> 8) & 63, k1 = (idx >> 14) & 63, b = idx >> 20;
            float gr = 0.f, gi = 0.f;
            for (int l2 = 0; l2 < 64; ++l2) { const size_t zi = ((size_t)(b * 64 + k1) * 64 + l2) * 256 + ch; const float zr = bf2f(Zr16[zi]), zim = bf2f(Zi16[zi]); const int j = (k2 * l2) & 63; const float c = trig[j], sn = trig[64 + j];
                gr += c * zr + sn * zim; gi += c * zim - sn * zr; }
            bf16* o = A4 + (size_t)(b * SEQ + k1 + 64 * k2) * KOUT + ch;
            o[0] = (bf16)f2bf(gr); o[256] = (bf16)f2bf(gi);
        }
    }
    xcd_barrier(bar);
    for (int u = F.vcu; u < 1024; u += F.G) ssd_out_unit(Q, F.lds, u, F.tid, F.wave, lane);
    xcd_barrier(bar);
    { pg8::Gemm g{A4, WoT, T, D, KOUT}; pg8::StaticOrder S; S.init(T, D, F.G, (int)blockIdx.x);
      pg8::EpiF32 E{Y2, D};
      pg8::gemm_phase<pg8::EpiF32, pg8::StaticOrder, true, true>(F.lds + RING_OFF, g, S, E); }
    xcd_barrier(bar);
    for (int row = gw; row < T; row += NGW) {
        const float* mb = mod + (size_t)(row >> 12) * NMOD;
        f32x4 v[4]; row_residual(v, Y2 + (size_t)row * D, OUT + (size_t)row * D, in[I_MPOST], mb + 5 * D, 1.0f, lane);
        row_store(OUT + (size_t)row * D, lane, v);
        const float rs = 1.0f / sqrtf(row_sumsq(v) * (1.0f / D) + EPS);
        row_mod_store(v, rs, in[I_F2PRE], mb + 6 * D, mb + 7 * D, Hb + (size_t)row * D, lane);
    }
    xcd_barrier(bar);
    { pg8::Gemm g{Hb, Wgu2, T, 2 * FF, D}; pg8::StaticOrder S; S.init(T, 2 * FF, F.G, (int)blockIdx.x);
      pg8::EpiSwiGLU E{ACT, FF};
      pg8::gemm_phase<pg8::EpiSwiGLU, pg8::StaticOrder, true, true>(F.lds + RING_OFF, g, S, E); }
    xcd_barrier(bar);
    { pg8::Gemm g{ACT, Wd2, T, D, FF}; pg8::StaticOrder S; S.init(T, D, F.G, (int)blockIdx.x);
      pg8::EpiF32 E{Y3, D};
      pg8::gemm_phase<pg8::EpiF32, pg8::StaticOrder, true, true>(F.lds + RING_OFF, g, S, E); }
    xcd_barrier(bar);
    for (int row = gw; row < T; row += NGW) {
        const float* mb = mod + (size_t)(row >> 12) * NMOD;
        f32x4 v[4]; row_residual(v, Y3 + (size_t)row * D, OUT + (size_t)row * D, in[I_F2POST], mb + 8 * D, 0.5f, lane);
        row_store(OUT + (size_t)row * D, lane, v);
    }
}

extern "C" void kernel_launch(void* const* d_in, const int* in_sizes, int n_in, void* d_out, int out_size, void* d_ws, size_t ws_size, hipStream_t stream) {
    static int grid = 0;
    if (grid == 0) {
        if (n_in != 27 || in_sizes[0] != T * D || out_size != T * D || ws_size < WS_END) { fprintf(stderr, "kernel_launch: unexpected shapes (n_in %d, in0 %d, out %d, ws %zu)\n", n_in, n_in > 0 ? in_sizes[0] : -1, out_size, ws_size); grid = -1; return; }
        int dev = 0, cus = 0;
        if (hipGetDevice(&dev) != hipSuccess || hipDeviceGetAttribute(&cus, hipDeviceAttributeMultiprocessorCount, dev) != hipSuccess) { grid = -1; return; }
        if (hipFuncSetAttribute((const void*)mk_fwd, hipFuncAttributeMaxDynamicSharedMemorySize, LDS_BYTES) != hipSuccess) { fprintf(stderr, "kernel_launch: hipFuncSetAttribute failed\n"); grid = -1; return; }
        (void)hipGetLastError();
        grid = cus;
    }
    if (grid < 0) return;
    if (hipMemsetAsync((char*)d_ws + WS_CTL, 0, CTL_ZERO_BYTES, stream) != hipSuccess) return;
    Args a{};
    for (int i = 0; i < 27; ++i) a.in[i] = (const float*)d_in[i];
    a.out = (float*)d_out; a.ws = (unsigned char*)d_ws;
    hipLaunchKernelGGL(mk_fwd, dim3(grid), dim3(NWAVES * 64), LDS_BYTES, stream, a);
}
```

```cpp
#include <hip/hip_runtime.h>
#include <cstdio>
#include <cstdint>
namespace pg8 {
#define PG8_LAS __attribute__((address_space(3)))
typedef unsigned short bf16_t;
typedef short bf16x8 __attribute__((ext_vector_type(8)));
typedef float f32x4 __attribute__((ext_vector_type(4)));
typedef unsigned u32x4 __attribute__((ext_vector_type(4)));
constexpr int BM = 256, BK = 64, HALF = 128, HTB = HALF * BK * 2  , STAGE_BYTES = 8 * HTB, NXCD = 8, WGM = 8;

__host__ __device__ __forceinline__ int lds_byte(int r, int c) { const int st = (r >> 4) * 2 + (c >> 5), rr = r & 15, cc = c & 31, ob = rr * 64 + cc * 2; return st * 1024 + (ob ^ (((ob >> 9) & 1) << 5)); }
__host__ __device__ __forceinline__ void stage_rc(int b, int& R, int& C) { const int st = b / 1024, sb = b % 1024, swz = sb ^ (((sb >> 9) & 1) << 5); R = (st >> 1) * 16 + swz / 64; C = (st & 1) * 32 + (swz % 64) / 2; }
__host__ __device__ __forceinline__ int perm32(int rho) { const int n = rho >> 4, i = rho & 15; return 8 * (i >> 2) + 4 * n + (i & 3); }

struct Unit { int pm, pn; };
struct Gemm { const bf16_t* A; const bf16_t* Bt; int M, N, K; };

struct StaticOrder {
    int nM, nN, nwg, G, c;
    __host__ __device__ void init(int M, int N, int G_, int c_) { nM = M / BM; nN = N / BM; nwg = nM * nN; G = G_; c = c_; }
    __host__ __device__ bool next(int i, Unit& u) const {
        const long L = (long)i * G + c; if (L >= nwg) return false;
        int wgid = (int)L; { const int q = nwg / NXCD, r = nwg % NXCD, xcd = wgid % NXCD, off = wgid / NXCD; wgid = (xcd < r ? xcd * (q + 1) : r * (q + 1) + (xcd - r) * q) + off; }
        const int nig = WGM * nN, gid = wgid / nig, fm = gid * WGM, gsz = (nM - fm) < WGM ? (nM - fm) : WGM;
        u.pm = fm + ((wgid % nig) % gsz); u.pn = (wgid % nig) / gsz; return true;
    }
    __device__ __forceinline__ void a_ready(const Unit&) const {}
    __device__ __forceinline__ void done(const Unit&) const {}
};
__device__ __forceinline__ unsigned cvt_pk_bf16(float lo, float hi) { unsigned r; asm volatile("v_cvt_pk_bf16_f32 %0, %1, %2" : "=v"(r) : "v"(lo), "v"(hi)); return r; }
typedef float f32x2 __attribute__((ext_vector_type(2)));
__device__ __forceinline__ float silu_f(float g) { return g * __builtin_amdgcn_rcpf(1.0f + __expf(-g)); }

struct EpiF32 {
    static constexpr bool PERM = false, AFTER_DRAIN = false;
    float* C; int ldc;
    __device__ __forceinline__ void operator()(const f32x4 (&acc)[2][2][4][2], const Unit& u, int wr, int wc, int fr, int fq) const {
        const int row0 = u.pm * BM + wr * 64 + fr, col0 = u.pn * BM + wc * 32 + 4 * fq;
#pragma unroll
        for (int ai = 0; ai < 2; ++ai)
#pragma unroll
            for (int m = 0; m < 4; ++m) { float* rowp = C + (size_t)(row0 + ai * HALF + m * 16) * ldc + col0;
#pragma unroll
                for (int bj = 0; bj < 2; ++bj)
#pragma unroll
                    for (int n = 0; n < 2; ++n) *(f32x4*)(rowp + bj * HALF + n * 16) = acc[ai][bj][m][n]; }
    }
};
struct EpiSwiGLU {
    static constexpr bool PERM = true, AFTER_DRAIN = false;
    bf16_t* O; int ldo;
    __device__ __forceinline__ void operator()(const f32x4 (&acc)[2][2][4][2], const Unit& u, int wr, int wc, int fr, int fq) const {
        const int row0 = u.pm * BM + wr * 64 + fr, col0 = u.pn * HALF + wc * 32 + 8 * fq;
#pragma unroll
        for (int ai = 0; ai < 2; ++ai)
#pragma unroll
            for (int m = 0; m < 4; ++m) { bf16_t* rowp = O + (size_t)(row0 + ai * HALF + m * 16) * ldo + col0;
                const f32x4 g0 = acc[ai][0][m][0], g1 = acc[ai][0][m][1], u0 = acc[ai][1][m][0], u1 = acc[ai][1][m][1];
                u32x4 w;
                w.x = cvt_pk_bf16(silu_f(g0[0]) * u0[0], silu_f(g0[1]) * u0[1]); w.y = cvt_pk_bf16(silu_f(g0[2]) * u0[2], silu_f(g0[3]) * u0[3]);
                w.z = cvt_pk_bf16(silu_f(g1[0]) * u1[0], silu_f(g1[1]) * u1[1]); w.w = cvt_pk_bf16(silu_f(g1[2]) * u1[2], silu_f(g1[3]) * u1[3]);
                *(u32x4*)rowp = w; }
    }
};
struct EpiProj {
    static constexpr bool PERM = true, AFTER_DRAIN = false;
    bf16_t* U; bf16_t* Zg; bf16_t* XBC; float* DT; int nlat;
    __device__ __forceinline__ void operator()(const f32x4 (&acc)[2][2][4][2], const Unit& u, int wr, int wc, int fr, int fq) const {
        const int row0 = u.pm * BM + wr * 64 + fr;
        if (u.pn < 11) {
            bf16_t* dst; int ld, cb;
            if (u.pn == 0) { if (u.pm >= nlat) return; dst = U; ld = 256; cb = 0; }
            else if (u.pn < 4) { if (u.pm >= nlat) return; dst = Zg; ld = 768; cb = (u.pn - 1) * BM; }
            else { dst = XBC; ld = 1792; cb = (u.pn - 4) * BM; }
            const int col0 = cb + wc * 32 + 8 * fq;
#pragma unroll
            for (int ai = 0; ai < 2; ++ai)
#pragma unroll
                for (int m = 0; m < 4; ++m) { bf16_t* rowp = dst + (size_t)(row0 + ai * HALF + m * 16) * ld + col0;
#pragma unroll
                    for (int bj = 0; bj < 2; ++bj) { const f32x4 v0 = acc[ai][bj][m][0], v1 = acc[ai][bj][m][1];
                        u32x4 w; w.x = cvt_pk_bf16(v0[0], v0[1]); w.y = cvt_pk_bf16(v0[2], v0[3]); w.z = cvt_pk_bf16(v1[0], v1[1]); w.w = cvt_pk_bf16(v1[2], v1[3]);
                        *(u32x4*)(rowp + bj * HALF) = w; } }
        } else if (wc == 0) {
#pragma unroll
            for (int ai = 0; ai < 2; ++ai)
#pragma unroll
                for (int m = 0; m < 4; ++m) { float* rowp = DT + (size_t)(row0 + ai * HALF + m * 16) * 32 + 8 * fq;
                    *(f32x4*)rowp = acc[ai][0][m][0]; *(f32x4*)(rowp + 4) = acc[ai][0][m][1]; }
        }
    }
};
template <class Epi, class Sched, bool ALIGN_EPI = false, bool SP2 = false>
__device__ __forceinline__ void gemm_phase(PG8_LAS unsigned char* lds, const Gemm g, const Sched& S, const Epi& E) {
    const int tid = threadIdx.x, wid = __builtin_amdgcn_readfirstlane(tid >> 6), lane = tid & 63, wr = wid >> 2, wc = wid & 3, fr = lane & 15, fq = lane >> 4;
    const int K = g.K, nt = K / BK;
    unsigned voffA[2], voffB[2];
#pragma unroll
    for (int i = 0; i < 2; ++i) { int R, C; stage_rc(tid * 16 + i * 8192, R, C); const int Rb = Epi::PERM ? ((R & ~31) + perm32(R & 31)) : R;
        voffA[i] = (unsigned)(R * K + C) * 2u; voffB[i] = (unsigned)(Rb * K + C) * 2u; }
    const size_t kstep = (size_t)(BK * 2);
    const size_t hstep = (size_t)HALF * K * 2;
    const size_t tstep = 2 * hstep;
    const unsigned ldsw = (unsigned)wid * 1024u;
    const int aoff = lds_byte(wr * 64 + fr, fq * 8), boff = lds_byte(wc * 32 + fr, fq * 8);
#define PG8_SA(b, h) (((b) * 2 + (h)) * HTB)
#define PG8_SB(b, h) ((4 + (b) * 2 + (h)) * HTB)
#define PG8_STAGE(bufoff, gbase, voff) do { _Pragma("unroll") for (int _i = 0; _i < 2; ++_i) \
        __builtin_amdgcn_global_load_lds((const unsigned*)((const char*)(gbase) + (voff)[_i]), (PG8_LAS unsigned*)(lds + (bufoff) + ldsw + _i * 8192), 16, 0, 0); } while (0)
#define PG8_LDA(dst, b, h) do { _Pragma("unroll") for (int m = 0; m < 4; ++m) _Pragma("unroll") for (int k = 0; k < 2; ++k) dst[m][k] = *(const PG8_LAS bf16x8*)(lds + PG8_SA(b, h) + aoff + m * 2048 + k * 1024); } while (0)
#define PG8_LDB(dst, b, h) do { _Pragma("unroll") for (int n = 0; n < 2; ++n) _Pragma("unroll") for (int k = 0; k < 2; ++k) dst[n][k] = *(const PG8_LAS bf16x8*)(lds + PG8_SB(b, h) + boff + n * 2048 + k * 1024); } while (0)
#define PG8_MMA(ai, bj, At, Bt) do { __builtin_amdgcn_s_setprio(1); _Pragma("unroll") for (int m = 0; m < 4; ++m) _Pragma("unroll") for (int n = 0; n < 2; ++n) _Pragma("unroll") for (int k = 0; k < 2; ++k) \
        acc[ai][bj][m][n] = __builtin_amdgcn_mfma_f32_16x16x32_bf16(Bt[n][k], At[m][k], acc[ai][bj][m][n], 0, 0, 0); __builtin_amdgcn_s_setprio(0); } while (0)
#define PG8_WAIT_V(n) asm volatile("s_waitcnt vmcnt(" #n ")" ::: "memory")
#define PG8_WAIT_L(n) asm volatile("s_waitcnt lgkmcnt(" #n ")" ::: "memory")
#define PG8_BAR __builtin_amdgcn_s_barrier()
#define PG8_SCHED __builtin_amdgcn_sched_barrier(0)
    Unit cur, nxt; int ui = 0;
    if (!S.next(0, cur)) return;
    f32x4 acc[2][2][4][2];
#pragma unroll
    for (int a = 0; a < 2; ++a)
#pragma unroll
        for (int b = 0; b < 2; ++b)
#pragma unroll
            for (int m = 0; m < 4; ++m)
#pragma unroll
                for (int n = 0; n < 2; ++n) acc[a][b][m][n] = (f32x4){0.f, 0.f, 0.f, 0.f};
    bf16x8 At[4][2], B0[2][2], B1[2][2];
    const char* cA = (const char*)g.A + (size_t)cur.pm * tstep; const char* cB = (const char*)g.Bt + (size_t)cur.pn * tstep;
    S.a_ready(cur);
    if constexpr (SP2) {
        PG8_STAGE(PG8_SB(0, 0), cB, voffB); PG8_STAGE(PG8_SB(0, 1), cB + hstep, voffB); PG8_STAGE(PG8_SA(0, 0), cA, voffA); PG8_STAGE(PG8_SA(0, 1), cA + hstep, voffA);
        if (wr == 1) PG8_BAR;
        PG8_WAIT_V(2); PG8_BAR;
        PG8_STAGE(PG8_SB(1, 0), cB + kstep, voffB); PG8_STAGE(PG8_SA(1, 0), cA + kstep, voffA); PG8_STAGE(PG8_SB(1, 1), cB + hstep + kstep, voffB);
        PG8_WAIT_V(6); PG8_BAR;
    } else {
        PG8_STAGE(PG8_SB(0, 0), cB, voffB); PG8_STAGE(PG8_SA(0, 0), cA, voffA); PG8_STAGE(PG8_SB(0, 1), cB + hstep, voffB); PG8_STAGE(PG8_SA(0, 1), cA + hstep, voffA);
        if (wr == 1) PG8_BAR;
        PG8_WAIT_V(4); PG8_BAR;
        PG8_STAGE(PG8_SB(1, 0), cB + kstep, voffB); PG8_STAGE(PG8_SA(1, 0), cA + kstep, voffA); PG8_STAGE(PG8_SB(1, 1), cB + hstep + kstep, voffB);
        PG8_WAIT_V(6); PG8_BAR;
    }
    for (;;) {
        const bool has_next = S.next(ui + 1, nxt);
        const char* nA = has_next ? (const char*)g.A + (size_t)nxt.pm * tstep : cA; const char* nB = has_next ? (const char*)g.Bt + (size_t)nxt.pn * tstep : cB;
        for (int t = 0; t < nt; t += 2) {
            const bool last = (t == nt - 2);
            const char* a1 = cA + (size_t)(t + 1) * kstep;
            const char* a2 = last ? nA : cA + (size_t)(t + 2) * kstep; const char* b2 = last ? nB : cB + (size_t)(t + 2) * kstep;
            const char* a3 = a2 + kstep; const char* b3 = b2 + kstep;
            if (last && has_next) S.a_ready(nxt);
            if constexpr (SP2) {
            PG8_LDB(B0, 0, 0); PG8_LDB(B1, 0, 1); PG8_SCHED; PG8_LDA(At, 0, 0); PG8_STAGE(PG8_SA(1, 1), a1 + hstep, voffA);
            PG8_WAIT_V(8); PG8_WAIT_L(0); PG8_BAR; PG8_MMA(0, 0, At, B0); PG8_MMA(0, 1, At, B1); PG8_BAR; PG8_SCHED;
            PG8_LDA(At, 0, 1); PG8_STAGE(PG8_SB(0, 0), b2, voffB); PG8_STAGE(PG8_SB(0, 1), b2 + hstep, voffB); PG8_STAGE(PG8_SA(0, 0), a2, voffA);
            PG8_WAIT_V(8); PG8_WAIT_L(0); PG8_BAR; PG8_MMA(1, 0, At, B0); PG8_MMA(1, 1, At, B1); PG8_BAR; PG8_SCHED;
            PG8_LDB(B0, 1, 0); PG8_LDB(B1, 1, 1); PG8_SCHED; PG8_LDA(At, 1, 0); PG8_STAGE(PG8_SA(0, 1), a2 + hstep, voffA);
            PG8_WAIT_V(8); PG8_WAIT_L(0); PG8_BAR; PG8_MMA(0, 0, At, B0); PG8_MMA(0, 1, At, B1); PG8_BAR; PG8_SCHED;
            PG8_LDA(At, 1, 1); PG8_STAGE(PG8_SB(1, 0), b3, voffB); PG8_STAGE(PG8_SB(1, 1), b3 + hstep, voffB); PG8_STAGE(PG8_SA(1, 0), a3, voffA);
            PG8_WAIT_V(8); PG8_WAIT_L(0); PG8_BAR; PG8_MMA(1, 0, At, B0); PG8_MMA(1, 1, At, B1); PG8_BAR; PG8_SCHED;
            } else {
            PG8_LDB(B0, 0, 0); PG8_SCHED; PG8_LDA(At, 0, 0); PG8_STAGE(PG8_SA(1, 1), a1 + hstep, voffA);
            PG8_WAIT_L(8); PG8_BAR; PG8_WAIT_L(0); PG8_MMA(0, 0, At, B0); PG8_BAR; PG8_SCHED;
            PG8_LDB(B1, 0, 1); PG8_STAGE(PG8_SB(0, 0), b2, voffB);
            PG8_BAR; PG8_WAIT_L(0); PG8_MMA(0, 1, At, B1); PG8_BAR;
            PG8_LDA(At, 0, 1); PG8_STAGE(PG8_SA(0, 0), a2, voffA);
            PG8_BAR; PG8_WAIT_L(0); PG8_MMA(1, 0, At, B0); PG8_BAR; PG8_SCHED;
            PG8_STAGE(PG8_SB(0, 1), b2 + hstep, voffB);
            PG8_WAIT_V(6); PG8_BAR; PG8_MMA(1, 1, At, B1); PG8_BAR;
            PG8_LDB(B0, 1, 0); PG8_SCHED; PG8_LDA(At, 1, 0); PG8_STAGE(PG8_SA(0, 1), a2 + hstep, voffA);
            PG8_WAIT_L(8); PG8_BAR; PG8_WAIT_L(0); PG8_MMA(0, 0, At, B0); PG8_BAR; PG8_SCHED;
            PG8_LDB(B1, 1, 1); PG8_STAGE(PG8_SB(1, 0), b3, voffB);
            PG8_BAR; PG8_WAIT_L(0); PG8_MMA(0, 1, At, B1); PG8_BAR;
            PG8_LDA(At, 1, 1); PG8_STAGE(PG8_SA(1, 0), a3, voffA);
            PG8_BAR; PG8_WAIT_L(0); PG8_MMA(1, 0, At, B0); PG8_BAR; PG8_SCHED;
            PG8_STAGE(PG8_SB(1, 1), b3 + hstep, voffB);
            PG8_WAIT_V(6); PG8_BAR; PG8_MMA(1, 1, At, B1); PG8_BAR;
            }
        }
        if constexpr (ALIGN_EPI) { if (wr == 0) PG8_BAR; }
        if constexpr (!Epi::AFTER_DRAIN) { E(acc, cur, wr, wc, fr, fq); S.done(cur); }
        if (!has_next) break;
#pragma unroll
        for (int a = 0; a < 2; ++a)
#pragma unroll
            for (int b = 0; b < 2; ++b)
#pragma unroll
                for (int m = 0; m < 4; ++m)
#pragma unroll
                    for (int n = 0; n < 2; ++n) acc[a][b][m][n] = (f32x4){0.f, 0.f, 0.f, 0.f};
        cur = nxt; cA = nA; cB = nB; ++ui;
        if constexpr (ALIGN_EPI) { if (wr == 1) PG8_BAR; }
    }
    PG8_WAIT_V(0);
    if constexpr (!ALIGN_EPI) { if (wr == 0) PG8_BAR; }
    PG8_BAR;
    if constexpr (Epi::AFTER_DRAIN) { E.fused(acc, cur, wr, wc, fr, fq, lds, wid, lane); S.done(cur); }
#undef PG8_SA
#undef PG8_SB
#undef PG8_STAGE
#undef PG8_LDA
#undef PG8_LDB
#undef PG8_MMA
#undef PG8_WAIT_V
#undef PG8_WAIT_L
#undef PG8_BAR
#undef PG8_SCHED
}
}

constexpr int NWAVES = 8;
constexpr int D = 1024, NB = 8, SEQ = 4096, CTXL = 256, T = NB * SEQ, TC = NB * CTXL, ROWS = T + TC;
constexpr int FF = 2816, NPROJ = 2840, NPROJ_PAD = 3072, KOUT = 1280, NMOD = 9 * D;
constexpr float EPS = 1e-6f;
constexpr int PC_U = 0, PC_Z = 256, PC_XBC = 1024, PROJ_LD = 2816;
constexpr size_t MiB = 1u << 20;
constexpr size_t WS_CTL = 0, CTL_ZERO_BYTES = 1 * MiB;
constexpr size_t WS_MOD = 65536;
constexpr size_t WS_WGU1 = 1 * MiB, WS_WD1 = 12 * MiB, WS_WGU2 = 18 * MiB, WS_WD2 = 29 * MiB, WS_WIN = 35 * MiB, WS_WOUT = 41 * MiB;
constexpr size_t WS_DT = 44 * MiB;
constexpr size_t WS_R1 = 49 * MiB;
constexpr size_t WS_R3 = 236 * MiB;
constexpr size_t WS_R4 = 355 * MiB;
constexpr size_t WS_R5 = 403 * MiB;
constexpr size_t WS_END = 507 * MiB;
constexpr int CW_BAR = 4096;

constexpr int RING_OFF = 0, RING_BYTES = 131072;
constexpr int LDSCTL_OFF = 145408, MISC_OFF = LDSCTL_OFF + 320, TRIG_OFF = LDSCTL_OFF + 1024;
constexpr int LDS_BYTES = 147456;

#define GAS __attribute__((address_space(1)))
#define LAS __attribute__((address_space(3)))
typedef unsigned short bf16;
typedef unsigned v4u __attribute__((ext_vector_type(4)));
typedef unsigned v2u __attribute__((ext_vector_type(2)));
typedef float f32x4 __attribute__((ext_vector_type(4)));
typedef GAS unsigned gu32;
#define LDS_WAIT() asm volatile("s_waitcnt lgkmcnt(0)" ::: "memory")
__device__ __forceinline__ unsigned f2bf(float f) { unsigned u = __builtin_bit_cast(unsigned, f); return (u + 0x7fffu + ((u >> 16) & 1u)) >> 16; }
__device__ __forceinline__ unsigned pk2(float lo, float hi) { return f2bf(lo) | (f2bf(hi) << 16); }
__device__ __forceinline__ float bflo(unsigned w) { return __uint_as_float(w << 16); }
__device__ __forceinline__ float bfhi(unsigned w) { return __uint_as_float(w & 0xffff0000u); }
__device__ __forceinline__ float bf2f(bf16 b) { return __uint_as_float((unsigned)b << 16); }
__device__ __forceinline__ float silu(float g) { return g / (1.0f + __expf(-g)); }
__device__ __forceinline__ float softplus(float v) { return fmaxf(v, 0.f) + log1pf(__expf(-fabsf(v))); }
__device__ __forceinline__ float wave_sum(float v) {
#pragma unroll
    for (int o = 1; o < 64; o <<= 1) v += __shfl_xor(v, o);
    return v;
}

#define XB_TMO      128
#define XB_XCNT(j)  (256  + 64 * (j))
#define XB_XSUB(j)  (1280 + 64 * (j))
#define XB_XGEN(j)  (2304 + 64 * (j))
#define XB_TOP      3328
#define XB_TOPGEN   3392
#define XCD_BAR_WORDS 3456
#define XB_SPIN_CAP (1u << 28)

__device__ __forceinline__ unsigned xb_ld(unsigned* p)              { return __hip_atomic_load(p, __ATOMIC_RELAXED, __HIP_MEMORY_SCOPE_AGENT); }
__device__ __forceinline__ unsigned xb_add(unsigned* p, unsigned v) { return __hip_atomic_fetch_add(p, v, __ATOMIC_RELAXED, __HIP_MEMORY_SCOPE_AGENT); }
__device__ __forceinline__ unsigned xb_xcc_id() { return (unsigned)__builtin_amdgcn_s_getreg((3 << 11) | 20) & 0xFu; }
#define XB_SPIN(cond, bar) do { unsigned _sp = 0; while (cond) { __builtin_amdgcn_s_sleep(1); \
    if ((++_sp & 255u) == 0u) { if (xb_ld(&(bar)[XB_TMO])) break; if (_sp > XB_SPIN_CAP) { atomicAdd(&(bar)[XB_TMO], 1u); break; } } } } while (0)

struct XcdBarrier {
    unsigned* bar; unsigned x;
    volatile LAS unsigned* st;
};

__device__ __forceinline__ XcdBarrier xcd_barrier_post(unsigned* bar, volatile LAS unsigned* st) {
    XcdBarrier b; b.bar = bar; b.x = xb_xcc_id(); b.st = st;
    if (threadIdx.x == 0) (void)xb_add(&bar[XB_XCNT(b.x)], 1u);
    return b;
}
__device__ __forceinline__ void xcd_barrier_complete(unsigned* bar, unsigned x, unsigned& nloc, unsigned& nx) {
    const unsigned G = gridDim.x * gridDim.y * gridDim.z;
    unsigned sum, cnt, mine, sp = 0u;
    for (;;) {
        sum = 0u; cnt = 0u; mine = 0u;
#pragma unroll
        for (unsigned j = 0; j < 16; ++j) { const unsigned c = xb_ld(&bar[XB_XCNT(j)]); sum += c; cnt += (c > 0u) ? 1u : 0u; mine = (j == x) ? c : mine; }
        if (sum == G) break;
        __builtin_amdgcn_s_sleep(1);
        if ((++sp & 255u) == 0u) { if (xb_ld(&bar[XB_TMO])) break; if (sp > XB_SPIN_CAP) { atomicAdd(&bar[XB_TMO], 1u); break; } }
    }
    nloc = mine > 0u ? mine : 1u; nx = cnt > 0u ? cnt : 1u;
}

__device__ __forceinline__ void xcd_barrier(const XcdBarrier& b) {
    asm volatile("s_waitcnt vmcnt(0)" ::: "memory");
    __syncthreads();
    if (threadIdx.x == 0) {
        unsigned* bar = b.bar;
        __builtin_amdgcn_s_waitcnt(0);
        unsigned nloc = b.st[0], nx = b.st[1];
        if (nloc == 0u) { xcd_barrier_complete(bar, b.x, nloc, nx); b.st[0] = nloc; b.st[1] = nx; }
        const unsigned old = xb_add(&bar[XB_XSUB(b.x)], 1u);
        const unsigned gen = old / nloc;
        if (old + 1u == (gen + 1u) * nloc) {
            __builtin_amdgcn_fence(__ATOMIC_RELEASE, "agent");
            asm volatile("s_waitcnt vmcnt(0)" ::: "memory");
            const unsigned og = xb_add(&bar[XB_TOP], 1u);
            const unsigned tg = og / nx;
            if (og + 1u == (tg + 1u) * nx) xb_add(&bar[XB_TOPGEN], 1u);
            else XB_SPIN(xb_ld(&bar[XB_TOPGEN]) == tg, bar);
            __builtin_amdgcn_fence(__ATOMIC_ACQUIRE, "agent");
            xb_add(&bar[XB_XGEN(b.x)], 1u);
            asm volatile("s_waitcnt vmcnt(0)" ::: "memory");
        } else {
            XB_SPIN(xb_ld(&bar[XB_XGEN(b.x)]) == gen, bar);
            __builtin_amdgcn_fence(__ATOMIC_ACQUIRE, "agent");
            asm volatile("s_waitcnt vmcnt(0)" ::: "memory");
        }
    }
    __syncthreads();
}


struct Args { const float* in[27]; float* out; unsigned char* ws; };
enum { I_X = 0, I_C, I_CTX, I_CCTX, I_ADAW, I_ADAB, I_F1PRE, I_F1POST, I_F1G, I_F1U, I_F1D, I_MPRE, I_MPOST, I_WIN, I_FW, I_CONVW, I_CONVB, I_DTB, I_ALOG, I_DSKIP, I_SSDN, I_WOUT,
       I_F2PRE, I_F2POST, I_F2G, I_F2U, I_F2D };

struct Frame {
    LAS unsigned char* lds;
    int tid, lane, wave, vcu, G, gw, NGW;
    const Args* a;
};

constexpr int TS = 272;
constexpr int NSLOT = 34;
typedef short bf16x8 __attribute__((ext_vector_type(8)));
#define MFMA16(a, b, c) __builtin_amdgcn_mfma_f32_16x16x32_bf16(a, b, c, 0, 0, 0)
template <int STR = TS>
__device__ __forceinline__ bf16x8 lds_frag(const LAS unsigned char* tile, int row0, int ks, int lane) {
    return *(const LAS bf16x8*)(tile + (row0 + (lane & 15)) * STR + (32 * ks + 8 * (lane >> 4)) * 2);
}
__device__ __forceinline__ void tile_copy(LAS unsigned char* tile, const bf16* src, int sld, int nrows, int tid) {
    for (int i = tid; i < nrows * 16; i += NWAVES * 64) { const int r = i >> 4, c = i & 15; *(LAS v4u*)(tile + r * TS + c * 16) = *(const v4u*)(src + (size_t)r * sld + c * 8); }
}
__device__ __forceinline__ void tr8x8_load(const bf16* src, int sld, v4u (&v)[8]) {
#pragma unroll
    for (int k = 0; k < 8; ++k) v[k] = *(const v4u*)(src + (size_t)k * sld);
}
template <int STR = TS>
__device__ __forceinline__ void tr8x8_store(const v4u (&v)[8], LAS unsigned char* dst) {
#pragma unroll
    for (int i = 0; i < 8; ++i) { const int wi = i >> 1, sh = (i & 1) * 16; v4u o;
        o.x = ((v[0][wi] >> sh) & 0xffffu) | (((v[1][wi] >> sh) & 0xffffu) << 16); o.y = ((v[2][wi] >> sh) & 0xffffu) | (((v[3][wi] >> sh) & 0xffffu) << 16);
        o.z = ((v[4][wi] >> sh) & 0xffffu) | (((v[5][wi] >> sh) & 0xffffu) << 16); o.w = ((v[6][wi] >> sh) & 0xffffu) | (((v[7][wi] >> sh) & 0xffffu) << 16);
        *(LAS v4u*)(dst + i * STR) = o; }
}
__device__ __forceinline__ float bfsel(unsigned w, int hi) { return hi ? bfhi(w) : bflo(w); }
__device__ __forceinline__ void tr8x8_store_scaled(const v4u (&v)[8], const float (&s)[8], LAS unsigned char* dst) {
#pragma unroll
    for (int i = 0; i < 8; ++i) { const int wi = i >> 1, hi = i & 1; v4u o;
        o.x = pk2(bfsel(v[0][wi], hi) * s[0], bfsel(v[1][wi], hi) * s[1]); o.y = pk2(bfsel(v[2][wi], hi) * s[2], bfsel(v[3][wi], hi) * s[3]);
        o.z = pk2(bfsel(v[4][wi], hi) * s[4], bfsel(v[5][wi], hi) * s[5]); o.w = pk2(bfsel(v[6][wi], hi) * s[6], bfsel(v[7][wi], hi) * s[7]);
        *(LAS v4u*)(dst + i * TS) = o; }
}
struct SsdBufs {
    const bf16* XC;
    const float* dtraw;
    float* DTV; float* ACU;
    float* DEC;
    bf16* S;
    const bf16* Zg;
    bf16* A4;
    const float* dtb; const float* alog; const float* dskip; const float* ssdn;
};
__device__ __forceinline__ void unit_decode(int u, int& b, int& g, int& slot, int& rbase) {
    if (u < 1024) { b = u >> 7; const int c = (u >> 2) & 31; g = u & 3; slot = 2 + c; rbase = b * SEQ + 128 * c; }
    else { const int j = u - 1024; b = j >> 3; const int cc = (j >> 2) & 1; g = j & 3; slot = cc; rbase = T + b * CTXL + 128 * cc; }
}

__device__ __forceinline__ void ssd_states_unit(const SsdBufs& Q, LAS unsigned char* L, int u, int tid, int wave, int lane) {
    int b, g, slot, rbase; unit_decode(u, b, g, slot, rbase);
    LAS unsigned char* BT = L;
    LAS unsigned char* XW = L + 128 * TS;
    LAS float* wts = (LAS float*)(L + 128 * TS + 6 * 64 * TS);
    LAS float* dAs = wts + 768;
    for (int t = tid; t < 768; t += NWAVES * 64) { const int hd = t >> 7, s = t & 127, dir = hd / 3, hh = 3 * g + hd % 3;
        const float dtv = softplus(Q.dtraw[(size_t)(rbase + s) * 32 + dir * 12 + hh] + Q.dtb[dir * 12 + hh]);
        dAs[t] = dtv * (-__expf(Q.alog[dir * 12 + hh])); wts[t] = dtv; }
    __syncthreads();
    if (wave < 6) { const int hd = wave, dir = hd / 3, hh = 3 * g + hd % 3;
        const int s0 = dir ? 127 - 2 * lane : 2 * lane, s1 = dir ? 126 - 2 * lane : 2 * lane + 1;
        const float a0 = dAs[hd * 128 + s0], a1 = dAs[hd * 128 + s1], pr = a0 + a1; float incl = pr;
#pragma unroll
        for (int o = 1; o < 64; o <<= 1) { const float t = __shfl_up(incl, o); if (lane >= o) incl += t; }
        const float A0 = incl - pr + a0, A1 = incl, tot = __shfl(incl, 63);
        const float d0 = wts[hd * 128 + s0], d1 = wts[hd * 128 + s1];
        const size_t gi = (size_t)(dir * 12 + hh) * ROWS + rbase;
        Q.ACU[gi + s0] = A0; Q.ACU[gi + s1] = A1; Q.DTV[gi + s0] = d0; Q.DTV[gi + s1] = d1;
        wts[hd * 128 + s0] = __expf(tot - A0) * d0; wts[hd * 128 + s1] = __expf(tot - A1) * d1;
        if (lane == 0) Q.DEC[((size_t)(dir * NB + b) * NSLOT + slot) * 12 + hh] = __expf(tot); }
    __syncthreads();
    for (int it = tid; it < 640; it += NWAVES * 64) {
        v4u v[8];
        if (it < 256) { const int cv = it & 15, rb = it >> 4;
            tr8x8_load(Q.XC + (size_t)(rbase + 8 * rb) * 1792 + 1280 + g * 128 + 8 * cv, 1792, v);
            tr8x8_store(v, BT + (8 * cv) * TS + (8 * rb) * 2); }
        else { const int j = it - 256, cv = j % 24, rb = j / 24, hl = cv >> 3, p0 = (8 * cv) & 63;
            tr8x8_load(Q.XC + (size_t)(rbase + 8 * rb) * 1792 + 512 + g * 192 + 8 * cv, 1792, v);
#pragma unroll
            for (int dir = 0; dir < 2; ++dir) { const int hd = dir * 3 + hl; float s[8];
#pragma unroll
                for (int k = 0; k < 8; ++k) s[k] = wts[hd * 128 + 8 * rb + k];
                tr8x8_store_scaled(v, s, XW + (hd * 64 + p0) * TS + (8 * rb) * 2); } }
    }
    __syncthreads();
    f32x4 acc[6][4];
#pragma unroll
    for (int hd = 0; hd < 6; ++hd)
#pragma unroll
        for (int pb = 0; pb < 4; ++pb) acc[hd][pb] = (f32x4){0.f, 0.f, 0.f, 0.f};
#pragma unroll
    for (int ks = 0; ks < 4; ++ks) { const bf16x8 bfr = lds_frag(BT, 16 * wave, ks, lane);
#pragma unroll
        for (int hd = 0; hd < 6; ++hd)
#pragma unroll
            for (int pb = 0; pb < 4; ++pb) acc[hd][pb] = MFMA16(bfr, lds_frag(XW, hd * 64 + 16 * pb, ks, lane), acc[hd][pb]); }
    const int n0 = 16 * wave + 4 * (lane >> 4), pl = lane & 15;
#pragma unroll
    for (int hd = 0; hd < 6; ++hd) { const int dir = hd / 3, hh = 3 * g + hd % 3;
        bf16* sp = Q.S + ((((size_t)(dir * NB + b) * NSLOT + slot) * 12 + hh) * 64) * 128;
#pragma unroll
        for (int pb = 0; pb < 4; ++pb) { v2u w; w.x = pk2(acc[hd][pb][0], acc[hd][pb][1]); w.y = pk2(acc[hd][pb][2], acc[hd][pb][3]);
            *(GAS v2u*)(sp + (size_t)(16 * pb + pl) * 128 + n0) = w; } }
    __syncthreads();
}

template <int DIR>
__device__ __forceinline__ void ssd_scan_item(const SsdBufs& Q, int b, int hh, int pv) {
    bf16* base = Q.S + (((size_t)(DIR * NB + b) * NSLOT) * 12 + hh) * 8192 + (size_t)pv * 8;
    const float* dec = Q.DEC + ((size_t)(DIR * NB + b) * NSLOT) * 12 + hh;
    constexpr size_t SL = (size_t)12 * 8192;
    v4u sv[NSLOT];
#pragma unroll
    for (int i = 0; i < NSLOT; ++i) { const int slot = DIR == 0 ? i : (i < 2 ? 1 - i : NSLOT + 1 - i); sv[i] = *(const v4u*)(base + slot * SL); }
    float h[8];
#pragma unroll
    for (int k = 0; k < 8; ++k) h[k] = 0.f;
#pragma unroll
    for (int i = 0; i < NSLOT; ++i) { const int slot = DIR == 0 ? i : (i < 2 ? 1 - i : NSLOT + 1 - i);
        v4u o; o.x = pk2(h[0], h[1]); o.y = pk2(h[2], h[3]); o.z = pk2(h[4], h[5]); o.w = pk2(h[6], h[7]);
        *(GAS v4u*)(base + slot * SL) = o;
        const float d = dec[slot * 12];
        h[0] = d * h[0] + bflo(sv[i].x); h[1] = d * h[1] + bfhi(sv[i].x); h[2] = d * h[2] + bflo(sv[i].y); h[3] = d * h[3] + bfhi(sv[i].y);
        h[4] = d * h[4] + bflo(sv[i].z); h[5] = d * h[5] + bfhi(sv[i].z); h[6] = d * h[6] + bflo(sv[i].w); h[7] = d * h[7] + bfhi(sv[i].w); }
}

__device__ __forceinline__ void ssd_out_unit(const SsdBufs& Q, LAS unsigned char* L, int u, int tid, int wave, int lane) {
    int b, g, slot, rbase; unit_decode(u, b, g, slot, rbase);
    LAS unsigned char* Cs = L;
    LAS unsigned char* BM = L + 128 * TS;
    LAS unsigned char* XT = L + 256 * TS;
    LAS unsigned char* HF = L + 320 * TS;
    LAS unsigned char* HB = L + 384 * TS;
    LAS float* AR = (LAS float*)(L + 448 * TS);
    tile_copy(Cs, Q.XC + (size_t)rbase * 1792 + g * 128, 1792, 128, tid);
    tile_copy(BM, Q.XC + (size_t)rbase * 1792 + 1280 + g * 128, 1792, 128, tid);
    for (int t = tid; t < 1536; t += NWAVES * 64) { const int hl = t / 512, q = (t >> 7) & 3, s = t & 127, dir = q & 1, hh = 3 * g + hl;
        const float* src = (q < 2 ? Q.ACU : Q.DTV) + (size_t)(dir * 12 + hh) * ROWS + rbase + s; AR[t] = *src; }
    __syncthreads();
    f32x4 gt[8];
#pragma unroll
    for (int sb = 0; sb < 8; ++sb) gt[sb] = (f32x4){0.f, 0.f, 0.f, 0.f};
#pragma unroll
    for (int ks = 0; ks < 4; ++ks) { const bf16x8 cfr = lds_frag(Cs, 16 * wave, ks, lane);
#pragma unroll
        for (int sb = 0; sb < 8; ++sb) gt[sb] = MFMA16(lds_frag(BM, 16 * sb, ks, lane), cfr, gt[sb]); }
    const int ll = 16 * wave + (lane & 15), q4 = 4 * (lane >> 4);
    float ss = 0.f;
    bf16* orow = Q.A4 + ((size_t)rbase + ll) * KOUT + 512 + g * 192;
#pragma unroll 1
    for (int hl = 0; hl < 3; ++hl) {
        const int hh = 3 * g + hl;
        __syncthreads();
        for (int it = tid; it < 128; it += NWAVES * 64) { const int cv = it & 7, rb = it >> 3; v4u v[8];
            tr8x8_load(Q.XC + (size_t)(rbase + 8 * rb) * 1792 + 512 + hh * 64 + 8 * cv, 1792, v);
            tr8x8_store(v, XT + (8 * cv) * TS + (8 * rb) * 2); }
        tile_copy(HF, Q.S + ((((size_t)(0 * NB + b) * NSLOT + slot) * 12 + hh) * 64) * 128, 128, 64, tid);
        tile_copy(HB, Q.S + ((((size_t)(1 * NB + b) * NSLOT + slot) * 12 + hh) * 64) * 128, 128, 64, tid);
        { const LAS float* Af = AR + hl * 512, * Ab = Af + 128, * df = Af + 256, * db = Af + 384;
          const float afl = Af[ll], abl = Ab[ll];
#pragma unroll
          for (int sb = 0; sb < 8; ++sb) { float m[4];
#pragma unroll
              for (int r = 0; r < 4; ++r) { const int s = 16 * sb + q4 + r;
                  const float wf = (s <= ll) ? __expf(afl - Af[s]) * df[s] : 0.f, wb = (s >= ll) ? __expf(abl - Ab[s]) * db[s] : 0.f;
                  m[r] = gt[sb][r] * (wf + wb); }
              v2u w; w.x = pk2(m[0], m[1]); w.y = pk2(m[2], m[3]);
              *(LAS v2u*)(BM + ll * TS + (16 * sb + q4) * 2) = w; asm volatile("" ::: "memory"); } }
        __syncthreads();
        f32x4 aD[4], aF[4], aB[4];
#pragma unroll
        for (int pb = 0; pb < 4; ++pb) { aD[pb] = (f32x4){0.f, 0.f, 0.f, 0.f}; aF[pb] = aD[pb]; aB[pb] = aD[pb]; }
#pragma unroll
        for (int ks = 0; ks < 4; ++ks) { const bf16x8 mfr = lds_frag(BM, 16 * wave, ks, lane), cfr = lds_frag(Cs, 16 * wave, ks, lane);
#pragma unroll
            for (int pb = 0; pb < 4; ++pb) { aD[pb] = MFMA16(lds_frag(XT, 16 * pb, ks, lane), mfr, aD[pb]);
                aF[pb] = MFMA16(lds_frag(HF, 16 * pb, ks, lane), cfr, aF[pb]); aB[pb] = MFMA16(lds_frag(HB, 16 * pb, ks, lane), cfr, aB[pb]); } }
        const float eaf = __expf(AR[hl * 512 + ll]), eab = __expf(AR[hl * 512 + 128 + ll]), dsk = Q.dskip[hh];
        const size_t row = (size_t)rbase + ll;
#pragma unroll
        for (int pb = 0; pb < 4; ++pb) { const int p = 16 * pb + q4;
            const v2u xw = *(const v2u*)(Q.XC + row * 1792 + 512 + hh * 64 + p), zw = *(const v2u*)(Q.Zg + row * 768 + hh * 64 + p);
            const float xs[4] = {bflo(xw.x), bfhi(xw.x), bflo(xw.y), bfhi(xw.y)}, zs[4] = {bflo(zw.x), bfhi(zw.x), bflo(zw.y), bfhi(zw.y)};
            float y[4];
#pragma unroll
            for (int r = 0; r < 4; ++r) { y[r] = (aD[pb][r] + eaf * aF[pb][r] + eab * aB[pb][r] + dsk * xs[r]) * silu(zs[r]);
                y[r] = __uint_as_float(f2bf(y[r]) << 16); ss += y[r] * y[r]; }
            v2u w; w.x = pk2(y[0], y[1]); w.y = pk2(y[2], y[3]);
            *(GAS v2u*)(orow + hl * 64 + p) = w; }
    }
    ss += __shfl_xor(ss, 16); ss += __shfl_xor(ss, 32);
    const float rs = 1.0f / sqrtf(ss * (1.0f / 192.0f) + EPS);
#pragma unroll 1
    for (int hl = 0; hl < 3; ++hl)
#pragma unroll
        for (int pb = 0; pb < 4; ++pb) { const int c = hl * 64 + 16 * pb + q4; const f32x4 gn = *(const f32x4*)(Q.ssdn + g * 192 + c);
            const v2u yw = *(const GAS v2u*)(orow + c);
            v2u w; w.x = pk2(bflo(yw.x) * rs * gn[0], bfhi(yw.x) * rs * gn[1]); w.y = pk2(bflo(yw.y) * rs * gn[2], bfhi(yw.y) * rs * gn[3]);
            *(GAS v2u*)(orow + c) = w; }
    __syncthreads();
}


constexpr int TS1 = 144;
__device__ __forceinline__ void dft1_build(LAS unsigned char* A1, const LAS float* trig, int tid) {
    for (int i = tid; i < 128 * 64; i += NWAVES * 64) { const int r = i >> 6, l1 = i & 63, k1 = r & 63, j = (k1 * l1) & 63;
        const float v = r < 64 ? trig[j] : -trig[64 + j]; *(LAS bf16*)(A1 + r * TS1 + l1 * 2) = (bf16)f2bf(v); }
}
__device__ __forceinline__ void dft1_unit(const bf16* U, bf16* Zr16, bf16* Zi16, LAS unsigned char* L, int u, int tid, int wave, int lane) {
    const int b = u >> 6, l2 = u & 63;
    LAS unsigned char* UT = L;
    LAS unsigned char* A1 = L + 256 * TS1;
    for (int it = tid; it < 256; it += NWAVES * 64) { const int cv = it & 31, rb = it >> 5; v4u v[8];
        tr8x8_load(U + ((size_t)b * SEQ + 64 * (8 * rb) + l2) * 256 + 8 * cv, 64 * 256, v);
        tr8x8_store<TS1>(v, UT + (8 * cv) * TS1 + (8 * rb) * 2); }
    __syncthreads();
    f32x4 ar[2][4], ai[2][4];
#pragma unroll
    for (int ct = 0; ct < 2; ++ct)
#pragma unroll
        for (int kb = 0; kb < 4; ++kb) { ar[ct][kb] = (f32x4){0.f, 0.f, 0.f, 0.f}; ai[ct][kb] = ar[ct][kb]; }
#pragma unroll
    for (int ks = 0; ks < 2; ++ks)
#pragma unroll
        for (int ct = 0; ct < 2; ++ct) { const bf16x8 ufr = lds_frag<TS1>(UT, 16 * (2 * wave + ct), ks, lane);
#pragma unroll
            for (int kb = 0; kb < 4; ++kb) { ar[ct][kb] = MFMA16(ufr, lds_frag<TS1>(A1, 16 * kb, ks, lane), ar[ct][kb]); ai[ct][kb] = MFMA16(ufr, lds_frag<TS1>(A1, 64 + 16 * kb, ks, lane), ai[ct][kb]); } }
#pragma unroll
    for (int kb = 0; kb < 4; ++kb) { const int k1 = 16 * kb + (lane & 15); const float ang = (float)(k1 * l2) / 2048.0f, tc = cospif(ang), ts = sinpif(ang);
#pragma unroll
        for (int ct = 0; ct < 2; ++ct) { const size_t o = (((size_t)(b * 64 + k1)) * 64 + l2) * 256 + 16 * (2 * wave + ct) + 4 * (lane >> 4);
            float zr[4], zi[4];
#pragma unroll
            for (int r = 0; r < 4; ++r) { zr[r] = ar[ct][kb][r] * tc + ai[ct][kb][r] * ts; zi[r] = ai[ct][kb][r] * tc - ar[ct][kb][r] * ts; }
            v2u w; w.x = pk2(zr[0], zr[1]); w.y = pk2(zr[2], zr[3]); *(GAS v2u*)(Zr16 + o) = w;
            w.x = pk2(zi[0], zi[1]); w.y = pk2(zi[2], zi[3]); *(GAS v2u*)(Zi16 + o) = w; } }
    __syncthreads();
}
__device__ __forceinline__ void dft2_build(LAS unsigned char* A2, const LAS float* trig, int tid) {
    for (int i = tid; i < 128 * 128; i += NWAVES * 64) { const int r = i >> 7, k = i & 127, k2 = r & 63, l2 = k & 63, j = (k2 * l2) & 63;
        const float c = trig[j], sn = trig[64 + j];
        const float v = r < 64 ? (k < 64 ? c : sn) : (k < 64 ? -sn : c); *(LAS bf16*)(A2 + r * TS + k * 2) = (bf16)f2bf(v); }
}
__device__ __forceinline__ void dft2_unit(const bf16* Zr16, const bf16* Zi16, bf16* A4, LAS unsigned char* L, int u, int tid, int wave, int lane) {
    const int b = u >> 6, k1 = u & 63;
    LAS unsigned char* ZT = L;
    LAS unsigned char* A2 = L + 256 * TS;
    for (int it = tid; it < 512; it += NWAVES * 64) { const int im = it >> 8, cv = it & 31, rb = (it >> 5) & 7; v4u v[8];
        tr8x8_load((im ? Zi16 : Zr16) + (((size_t)(b * 64 + k1)) * 64 + 8 * rb) * 256 + 8 * cv, 256, v);
        tr8x8_store(v, ZT + (8 * cv) * TS + (64 * im + 8 * rb) * 2); }
    __syncthreads();
    f32x4 acc[2][8];
#pragma unroll
    for (int ct = 0; ct < 2; ++ct)
#pragma unroll
        for (int jt = 0; jt < 8; ++jt) acc[ct][jt] = (f32x4){0.f, 0.f, 0.f, 0.f};
#pragma unroll
    for (int ks = 0; ks < 4; ++ks)
#pragma unroll
        for (int ct = 0; ct < 2; ++ct) { const bf16x8 zfr = lds_frag(ZT, 16 * (2 * wave + ct), ks, lane);
#pragma unroll
            for (int jt = 0; jt < 8; ++jt) acc[ct][jt] = MFMA16(zfr, lds_frag(A2, 16 * jt, ks, lane), acc[ct][jt]); }
#pragma unroll
    for (int jt = 0; jt < 8; ++jt) { const int k2 = 16 * (jt & 3) + (lane & 15);
        bf16* orow = A4 + ((size_t)b * SEQ + k1 + 64 * k2) * KOUT + (jt >= 4 ? 256 : 0);
#pragma unroll
        for (int ct = 0; ct < 2; ++ct) { v2u w; w.x = pk2(acc[ct][jt][0], acc[ct][jt][1]); w.y = pk2(acc[ct][jt][2], acc[ct][jt][3]);
            *(GAS v2u*)(orow + 16 * (2 * wave + ct) + 4 * (lane >> 4)) = w; } }
    __syncthreads();
}

__device__ __forceinline__ void transpose_item(const float* W, int K, int N, bf16* WT, int dstld, int koff, int mode, LAS float* scr, int item, int lane) {
    const int nblk = (N + 31) / 32, kb = item / nblk, nb = item % nblk, k0 = 64 * kb, n0 = 32 * nb;
    const int nn = n0 + (lane & 31);
#pragma unroll 8
    for (int i = 0; i < 32; ++i) { const int kk = 2 * i + (lane >> 5); scr[kk * 33 + (lane & 31)] = (nn < N) ? W[(size_t)(k0 + kk) * N + nn] : 0.f; }
    LDS_WAIT(); asm volatile("" ::: "memory");
    const int c = lane & 7;
#pragma unroll
    for (int j = 0; j < 4; ++j) { const int nl = (lane >> 3) + 8 * j, n = n0 + nl; const LAS float* s = scr + (8 * c) * 33 + nl;
        v4u o; o.x = pk2(s[0 * 33], s[1 * 33]); o.y = pk2(s[2 * 33], s[3 * 33]); o.z = pk2(s[4 * 33], s[5 * 33]); o.w = pk2(s[6 * 33], s[7 * 33]);
        const int row = (mode == 0) ? n : (256 * (n >> 7) + (n & 127) + (mode == 2 ? 128 : 0));
        if (n < N) *(GAS v4u*)(WT + (size_t)row * dstld + koff + k0 + 8 * c) = o; }
    LDS_WAIT(); asm volatile("" ::: "memory");
}

__device__ __forceinline__ void fold_item(const float* fw, const float* wout, bf16* WoT, const LAS float* trig, int item, int lane) {
    const int nq = item & 3, dblk = (item >> 2) & 7, cs = (item >> 5) & 1, h = item >> 6;
    float t[8];
#pragma unroll
    for (int j = 0; j < 8; ++j) t[j] = 0.f;
    for (int m = 0; m < 64; ++m) { const float f = fw[(h * 64 + m) * 64 + lane];
#pragma unroll
        for (int j = 0; j < 8; ++j) { const int d = 8 * dblk + j; t[j] += trig[cs * 64 + ((d * m) & 63)] * f; } }
    f32x4 acc[8];
#pragma unroll
    for (int j = 0; j < 8; ++j) { t[j] *= (1.0f / 512.0f); acc[j] = (f32x4){0.f, 0.f, 0.f, 0.f}; }
    const int n = nq * 256 + lane * 4;
    for (int e = 0; e < 64; ++e) { const f32x4 w = *(const f32x4*)(wout + (size_t)(64 * h + e) * D + n);
#pragma unroll
        for (int j = 0; j < 8; ++j) { const float tj = __shfl(t[j], e); acc[j] += w * tj; } }
#pragma unroll
    for (int q = 0; q < 4; ++q) { v4u o; o.x = pk2(acc[0][q], acc[1][q]); o.y = pk2(acc[2][q], acc[3][q]); o.z = pk2(acc[4][q], acc[5][q]); o.w = pk2(acc[6][q], acc[7][q]);
        *(GAS v4u*)(WoT + (size_t)(n + q) * KOUT + cs * 256 + 64 * h + 8 * dblk) = o; }
}

__device__ __forceinline__ void mod_item_wg(const float* adaw, const float* adab, float* mod, const LAS float* sc, LAS float* red, int item, int wave, int lane, int tid) {
    const int kq = lane >> 4, c4 = lane & 15, col = item * 64 + 4 * c4;
    f32x4 acc[9];
#pragma unroll
    for (int r = 0; r < 9; ++r) acc[r] = (f32x4){0.f, 0.f, 0.f, 0.f};
#pragma unroll 8
    for (int s = 0; s < 32; ++s) { const int row = 128 * wave + 4 * s + kq; const f32x4 w = *(const f32x4*)(adaw + (size_t)row * NMOD + col);
#pragma unroll
        for (int r = 0; r < 9; ++r) acc[r] += w * sc[r * D + row]; }
#pragma unroll
    for (int r = 0; r < 9; ++r)
#pragma unroll
        for (int q = 0; q < 4; ++q) { float v = acc[r][q]; v += __shfl_xor(v, 16); v += __shfl_xor(v, 32); if (kq == 0) red[(wave * 9 + r) * 64 + 4 * c4 + q] = v; }
    __syncthreads();
    for (int o = tid; o < 9 * 64; o += NWAVES * 64) { const int r = o >> 6, c = o & 63; float v = adab[item * 64 + c];
#pragma unroll
        for (int w = 0; w < NWAVES; ++w) v += red[(w * 9 + r) * 64 + c];
        mod[r * NMOD + item * 64 + c] = v; }
}

__device__ __forceinline__ void row_load(const float* p, int lane, f32x4 (&v)[4]) {
#pragma unroll
    for (int j = 0; j < 4; ++j) v[j] = *(const f32x4*)(p + 4 * (lane + 64 * j));
}
__device__ __forceinline__ float row_sumsq(const f32x4 (&v)[4]) {
    float s = 0.f;
#pragma unroll
    for (int j = 0; j < 4; ++j) s += (v[j][0] * v[j][0] + v[j][1] * v[j][1]) + (v[j][2] * v[j][2] + v[j][3] * v[j][3]);
    return wave_sum(s);
}
__device__ __forceinline__ void row_mod_store(const f32x4 (&v)[4], float rstd, const float* g, const float* shift, const float* scale, bf16* orow, int lane) {
#pragma unroll
    for (int j = 0; j < 4; ++j) { const int c = 4 * (lane + 64 * j);
        const f32x4 gg = *(const f32x4*)(g + c), sh = *(const f32x4*)(shift + c), sc = *(const f32x4*)(scale + c);
        const f32x4 o = (v[j] * rstd * gg) * (sc + 1.0f) + sh;
        v2u w; w.x = pk2(o[0], o[1]); w.y = pk2(o[2], o[3]);
        *(GAS v2u*)(orow + c) = w; }
}
__device__ __forceinline__ void row_residual(f32x4 (&v)[4], const float* yrow, const float* base, const float* gpost, const float* gate, float gwt, int lane) {
    f32x4 y[4]; row_load(yrow, lane, y);
    const float ry = 1.0f / sqrtf(row_sumsq(y) * (1.0f / D) + EPS);
#pragma unroll
    for (int j = 0; j < 4; ++j) { const int c = 4 * (lane + 64 * j);
        const f32x4 b = *(const f32x4*)(base + c), gp = *(const f32x4*)(gpost + c), gt = *(const f32x4*)(gate + c);
        v[j] = b + gt * gwt * (y[j] * ry * gp); }
}
__device__ __forceinline__ void row_store(float* p, int lane, const f32x4 (&v)[4]) {
#pragma unroll
    for (int j = 0; j < 4; ++j) *(f32x4*)(p + 4 * (lane + 64 * j)) = v[j];
}


#define DBG_HASHED 0
#ifndef DBG_STAGE
#define DBG_STAGE 0
#endif
__device__ __forceinline__ float dbg_hash(float v) { unsigned u = __float_as_uint(v); u *= 2654435761u; u ^= u >> 15; u *= 2246822519u; u ^= u >> 13; return (float)((int)(u & 0xffffu) - 32768) * (1.0f / 32.0f); }
#define DBG_DUMP(stage, expr) do { if (DBG_STAGE == (stage)) { for (size_t i_ = (size_t)gw * 64 + lane; i_ < (size_t)T * D; i_ += (size_t)NGW * 64) { const size_t row_ = i_ >> 10, col_ = i_ & 1023; OUT[i_] = DBG_HASHED ? dbg_hash(expr) : (expr); } return; } } while (0)
__global__ void __launch_bounds__(NWAVES * 64, 2) mk_fwd(Args args) {
    extern __shared__ __attribute__((aligned(16))) unsigned char lds_raw[];
    Frame F;
    F.lds = (LAS unsigned char*)lds_raw;
    F.tid = threadIdx.x; F.lane = F.tid & 63; F.wave = __builtin_amdgcn_readfirstlane(F.tid >> 6);
    F.G = gridDim.x; { const int bx = blockIdx.x; F.vcu = (F.G % 8 == 0) ? (bx % 8) * (F.G / 8) + bx / 8 : bx; }
    F.gw = F.vcu * NWAVES + F.wave; F.NGW = F.G * NWAVES;
    const int lane = F.lane, gw = F.gw, NGW = F.NGW;
    unsigned char* ws = args.ws;
    const float* const* in = args.in;
    gu32* ctl = (gu32*)(ws + WS_CTL);
    float* mod = (float*)(ws + WS_MOD);
    bf16* Wgu1 = (bf16*)(ws + WS_WGU1); bf16* Wd1 = (bf16*)(ws + WS_WD1); bf16* Wgu2 = (bf16*)(ws + WS_WGU2); bf16* Wd2 = (bf16*)(ws + WS_WD2);
    bf16* Win = (bf16*)(ws + WS_WIN); bf16* WoT = (bf16*)(ws + WS_WOUT);
    float* dtraw = (float*)(ws + WS_DT);
    bf16* Hb = (bf16*)(ws + WS_R5);
    bf16* ACT = (bf16*)(ws + WS_R1);
    bf16* XBR = (bf16*)(ws + WS_R1);
    bf16* Ub = (bf16*)(ws + WS_R1 + 119 * MiB);
    bf16* Zr16 = (bf16*)(ws + WS_R1 + 135 * MiB); bf16* Zi16 = (bf16*)(ws + WS_R1 + 151 * MiB);
    float* DTV = (float*)(ws + WS_R1 + 167 * MiB); float* ACU = (float*)(ws + WS_R1 + 171 * MiB); float* DEC = (float*)(ws + WS_R1 + 175 * MiB);
    bf16* XC = (bf16*)(ws + WS_R3);
    bf16* Zg = (bf16*)(ws + WS_R4);
    bf16* Sb = (bf16*)(ws + WS_R5);
    float* Y1 = (float*)(ws + WS_R3);
    float* Y2 = (float*)(ws + WS_R3);
    float* Y3 = (float*)(ws + WS_R3);
    bf16* A4 = (bf16*)(ws + WS_R1);
    float* OUT = args.out;

    for (int u = F.tid; u < (LDS_BYTES - LDSCTL_OFF) / 4; u += NWAVES * 64) ((LAS unsigned*)(F.lds + LDSCTL_OFF))[u] = 0u;
    __syncthreads();
    LAS float* trig = (LAS float*)(F.lds + TRIG_OFF);
    if (F.tid < 64) { trig[F.tid] = cospif((float)F.tid / 32.0f); trig[64 + F.tid] = sinpif((float)F.tid / 32.0f); }
    XcdBarrier bar = xcd_barrier_post((unsigned*)(ctl + CW_BAR), (volatile LAS unsigned*)(F.lds + MISC_OFF) + 8);
    __syncthreads();

    {
        LAS float* sc = (LAS float*)(F.lds + RING_OFF);
        for (int i = F.tid; i < 9 * D; i += NWAVES * 64) { const int r = i >> 10, k = i & 1023; const float v = (r < 8) ? in[I_C][r * D + k] : in[I_CCTX][k]; sc[i] = silu(v); }
        __syncthreads();
        LAS float* scr = (LAS float*)(F.lds + RING_OFF + 40960 + F.wave * 8448);
        if (F.vcu < 144) mod_item_wg(in[I_ADAW], in[I_ADAB], mod, sc, (LAS float*)(F.lds + RING_OFF + 110592), F.vcu, F.wave, lane, F.tid);
        constexpr int I_FOLD = 256, I_MODN = 0, I_GU = 16 * 88, I_DN = 44 * 32, I_WINN = 16 * 89, I_WO = 12 * 32;
        constexpr int NITEMS = I_FOLD + I_MODN + 2 * (2 * I_GU + I_DN) + I_WINN + I_WO;
        for (int it = gw; it < NITEMS; it += NGW) {
            int r = it;
            if (r < I_FOLD) { fold_item(in[I_FW], in[I_WOUT], WoT, trig, r, lane); continue; } r -= I_FOLD;
            if (r < I_GU) { transpose_item(in[I_F1G], D, FF, Wgu1, D, 0, 1, scr, r, lane); continue; } r -= I_GU;
            if (r < I_GU) { transpose_item(in[I_F1U], D, FF, Wgu1, D, 0, 2, scr, r, lane); continue; } r -= I_GU;
            if (r < I_DN) { transpose_item(in[I_F1D], FF, D, Wd1, FF, 0, 0, scr, r, lane); continue; } r -= I_DN;
            if (r < I_GU) { transpose_item(in[I_F2G], D, FF, Wgu2, D, 0, 1, scr, r, lane); continue; } r -= I_GU;
            if (r < I_GU) { transpose_item(in[I_F2U], D, FF, Wgu2, D, 0, 2, scr, r, lane); continue; } r -= I_GU;
            if (r < I_DN) { transpose_item(in[I_F2D], FF, D, Wd2, FF, 0, 0, scr, r, lane); continue; } r -= I_DN;
            if (r < I_WINN) { transpose_item(in[I_WIN], D, NPROJ, Win, D, 0, 0, scr, r, lane); continue; } r -= I_WINN;
            transpose_item(in[I_WOUT] + (size_t)256 * D, 768, D, WoT, KOUT, 512, 0, scr, r, lane);
        }
        { GAS v4u* z = (GAS v4u*)(Win + (size_t)NPROJ * D); const int nz = (NPROJ_PAD - NPROJ) * D / 8;
          for (int i = gw * 64 + lane; i < nz; i += NGW * 64) z[i] = (v4u){0u, 0u, 0u, 0u}; }
    }
    xcd_barrier(bar);

    for (int row = gw; row < ROWS; row += NGW) {
        const float* src = row < T ? in[I_X] + (size_t)row * D : in[I_CTX] + (size_t)(row - T) * D;
        const float* mb = mod + (size_t)(row < T ? (row >> 12) : 8) * NMOD;
        f32x4 v[4]; row_load(src, lane, v);
        const float rs = 1.0f / sqrtf(row_sumsq(v) * (1.0f / D) + EPS);
        row_mod_store(v, rs, in[I_F1PRE], mb + 0 * D, mb + 1 * D, Hb + (size_t)row * D, lane);
    }
    xcd_barrier(bar);
    DBG_DUMP(1, bf2f(Hb[row_ * D + col_]));

    { pg8::Gemm g{Hb, Wgu1, ROWS, 2 * FF, D}; pg8::StaticOrder S; S.init(ROWS, 2 * FF, F.G, (int)blockIdx.x);
      pg8::EpiSwiGLU E{ACT, FF};
      pg8::gemm_phase<pg8::EpiSwiGLU, pg8::StaticOrder, true, true>(F.lds + RING_OFF, g, S, E); }
    xcd_barrier(bar);
    DBG_DUMP(2, bf2f(ACT[row_ * FF + col_]));
    { pg8::Gemm g{ACT, Wd1, ROWS, D, FF}; pg8::StaticOrder S; S.init(ROWS, D, F.G, (int)blockIdx.x);
      pg8::EpiF32 E{Y1, D};
      pg8::gemm_phase<pg8::EpiF32, pg8::StaticOrder, true, true>(F.lds + RING_OFF, g, S, E); }
    xcd_barrier(bar);
    DBG_DUMP(3, Y1[row_ * D + col_]);
    for (int row = gw; row < ROWS; row += NGW) {
        const float* base = row < T ? in[I_X] + (size_t)row * D : in[I_CTX] + (size_t)(row - T) * D;
        const float* mb = mod + (size_t)(row < T ? (row >> 12) : 8) * NMOD;
        f32x4 v[4]; row_residual(v, Y1 + (size_t)row * D, base, in[I_F1POST], mb + 2 * D, 0.5f, lane);
        if (row < T) row_store(OUT + (size_t)row * D, lane, v);
        const float rs = 1.0f / sqrtf(row_sumsq(v) * (1.0f / D) + EPS);
        row_mod_store(v, rs, in[I_MPRE], mb + 3 * D, mb + 4 * D, Hb + (size_t)row * D, lane);
    }
    xcd_barrier(bar);
    DBG_DUMP(4, bf2f(Hb[row_ * D + col_]));
    { pg8::Gemm g{Hb, Win, ROWS, NPROJ_PAD, D}; pg8::StaticOrder S; S.init(ROWS, NPROJ_PAD, F.G, (int)blockIdx.x);
      pg8::EpiProj E{Ub, Zg, XBR, dtraw, T / 256};
      pg8::gemm_phase<pg8::EpiProj, pg8::StaticOrder, true, true>(F.lds + RING_OFF, g, S, E); }
    xcd_barrier(bar);

    const int GT = F.G * NWAVES * 64, gtid = F.vcu * NWAVES * 64 + F.tid;
    SsdBufs Q{XC, dtraw, DTV, ACU, DEC, Sb, Zg, A4, in[I_DTB], in[I_ALOG], in[I_DSKIP], in[I_SSDN]};
    {
        const float* convw = in[I_CONVW]; const float* convb = in[I_CONVB];
        for (int it = gtid; it < (ROWS / 16) * 224; it += GT) {
            const int cv = it % 224, strip = it / 224, row0 = strip * 16, ch = 8 * cv;
            const int l0 = row0 < T ? (row0 & (SEQ - 1)) : ((row0 - T) & (CTXL - 1)), len = row0 < T ? SEQ : CTXL;
            float w0[8], w1[8], w2[8], bb[8];
#pragma unroll
            for (int q = 0; q < 2; ++q) { const f32x4 a = *(const f32x4*)(convw + ch + 4 * q), b1 = *(const f32x4*)(convw + 1792 + ch + 4 * q), c = *(const f32x4*)(convw + 3584 + ch + 4 * q), d = *(const f32x4*)(convb + ch + 4 * q);
#pragma unroll
                for (int e = 0; e < 4; ++e) { w0[4 * q + e] = a[e]; w1[4 * q + e] = b1[e]; w2[4 * q + e] = c[e]; bb[4 * q + e] = d[e]; } }
            const bf16* src = XBR + (size_t)row0 * 1792 + ch; bf16* dst = XC + (size_t)row0 * 1792 + ch;
            v4u prev = (l0 > 0) ? *(const v4u*)(src - 1792) : (v4u){0u, 0u, 0u, 0u}, cur = *(const v4u*)src;
#pragma unroll 4
            for (int r = 0; r < 16; ++r) {
                const v4u nxt = (l0 + r + 1 < len) ? *(const v4u*)(src + (size_t)(r + 1) * 1792) : (v4u){0u, 0u, 0u, 0u};
                float o[8];
#pragma unroll
                for (int e = 0; e < 8; ++e) { const int wi = e >> 1, hi = e & 1; o[e] = silu(bb[e] + w0[e] * bfsel(prev[wi], hi) + w1[e] * bfsel(cur[wi], hi) + w2[e] * bfsel(nxt[wi], hi)); }
                v4u ov; ov.x = pk2(o[0], o[1]); ov.y = pk2(o[2], o[3]); ov.z = pk2(o[4], o[5]); ov.w = pk2(o[6], o[7]);
                *(GAS v4u*)(dst + (size_t)r * 1792) = ov; prev = cur; cur = nxt; }
        }
    }
    {
        dft1_build(F.lds + 256 * TS1, trig, F.tid); __syncthreads();
        for (int u = F.vcu; u < 512; u += F.G) dft1_unit(Ub, Zr16, Zi16, F.lds, u, F.tid, F.wave, lane);
    }
    xcd_barrier(bar);
    for (int u = F.vcu; u < 1088; u += F.G) ssd_states_unit(Q, F.lds, u, F.tid, F.wave, lane);
    xcd_barrier(bar);
    {
        for (int it = gtid; it < 2 * NB * 12 * 1024; it += GT) { const int pv = it & 1023, hh = (it >> 10) % 12, b = (it / (1024 * 12)) & 7, dir = it / (1024 * 12 * NB);
            if (dir == 0) ssd_scan_item<0>(Q, b, hh, pv); else ssd_scan_item<1>(Q, b, hh, pv); }
    }
    {
        dft2_build(F.lds + 256 * TS, trig, F.tid); __syncthreads();
        for (int u = F.vcu; u < 512; u += F.G) dft2_unit(Zr16, Zi16, A4, F.lds, u, F.tid, F.wave, lane);
    }
    xcd_barrier(bar);
    for (int u = F.vcu; u < 1024; u += F.G) ssd_out_unit(Q, F.lds, u, F.tid, F.wave, lane);
    xcd_barrier(bar);
    { pg8::Gemm g{A4, WoT, T, D, KOUT}; pg8::StaticOrder S; S.init(T, D, F.G, (int)blockIdx.x);
      pg8::EpiF32 E{Y2, D};
      pg8::gemm_phase<pg8::EpiF32, pg8::StaticOrder, true, true>(F.lds + RING_OFF, g, S, E); }
    xcd_barrier(bar);
    for (int row = gw; row < T; row += NGW) {
        const float* mb = mod + (size_t)(row >> 12) * NMOD;
        f32x4 v[4]; row_residual(v, Y2 + (size_t)row * D, OUT + (size_t)row * D, in[I_MPOST], mb + 5 * D, 1.0f, lane);
        row_store(OUT + (size_t)row * D, lane, v);
        const float rs = 1.0f / sqrtf(row_sumsq(v) * (1.0f / D) + EPS);
        row_mod_store(v, rs, in[I_F2PRE], mb + 6 * D, mb + 7 * D, Hb + (size_t)row * D, lane);
    }
    xcd_barrier(bar);
    { pg8::Gemm g{Hb, Wgu2, T, 2 * FF, D}; pg8::StaticOrder S; S.init(T, 2 * FF, F.G, (int)blockIdx.x);
      pg8::EpiSwiGLU E{ACT, FF};
      pg8::gemm_phase<pg8::EpiSwiGLU, pg8::StaticOrder, true, true>(F.lds + RING_OFF, g, S, E); }
    xcd_barrier(bar);
    { pg8::Gemm g{ACT, Wd2, T, D, FF}; pg8::StaticOrder S; S.init(T, D, F.G, (int)blockIdx.x);
      pg8::EpiF32 E{Y3, D};
      pg8::gemm_phase<pg8::EpiF32, pg8::StaticOrder, true, true>(F.lds + RING_OFF, g, S, E); }
    xcd_barrier(bar);
    for (int row = gw; row < T; row += NGW) {
        const float* mb = mod + (size_t)(row >> 12) * NMOD;
        f32x4 v[4]; row_residual(v, Y3 + (size_t)row * D, OUT + (size_t)row * D, in[I_F2POST], mb + 8 * D, 0.5f, lane);
        row_store(OUT + (size_t)row * D, lane, v);
    }
}

extern "C" void kernel_launch(void* const* d_in, const int* in_sizes, int n_in, void* d_out, int out_size, void* d_ws, size_t ws_size, hipStream_t stream) {
    static int grid = 0;
    if (grid == 0) {
        if (n_in != 27 || in_sizes[0] != T * D || out_size != T * D || ws_size < WS_END) { fprintf(stderr, "kernel_launch: unexpected shapes (n_in %d, in0 %d, out %d, ws %zu)\n", n_in, n_in > 0 ? in_sizes[0] : -1, out_size, ws_size); grid = -1; return; }
        int dev = 0, cus = 0;
        if (hipGetDevice(&dev) != hipSuccess || hipDeviceGetAttribute(&cus, hipDeviceAttributeMultiprocessorCount, dev) != hipSuccess) { grid = -1; return; }
        if (hipFuncSetAttribute((const void*)mk_fwd, hipFuncAttributeMaxDynamicSharedMemorySize, LDS_BYTES) != hipSuccess) { fprintf(stderr, "kernel_launch: hipFuncSetAttribute failed\n"); grid = -1; return; }
        (void)hipGetLastError();
        grid = cus;
    }
    if (grid < 0) return;
    if (hipMemsetAsync((char*)d_ws + WS_CTL, 0, CTL_ZERO_BYTES, stream) != hipSuccess) return;
    Args a{};
    for (int i = 0; i < 27; ++i) a.in[i] = (const float*)d_in[i];
    a.out = (float*)d_out; a.ws = (unsigned char*)d_ws;
    hipLaunchKernelGGL(mk_fwd, dim3(grid), dim3(NWAVES * 64), LDS_BYTES, stream, a);
}
```
